# Optimizing an MI355X kernel written in HIP

```python
import math
import jax, jax.numpy as jnp
from jax import lax
import numpy as np


D_MODEL = 1024
BATCH = 16
SEQ = 4096
DEPTH = 2
DEC_BATCH = 8
DEC_SEQ = 2048
PAST_LEN = 128

N_MIXERS = 2
N_ATTN_LAYERS = (DEPTH + 1) // 2
N_FNET_LAYERS = DEPTH // 2
DA_HEADS = 8
DA_HEAD_DIM = D_MODEL // DA_HEADS // 2
ROPE_THETA = 10000.0
Q_BLOCK = 128
FNET_GROUPS = 4
FNET_GROUP_DIM = D_MODEL // FNET_GROUPS
MEM_TOKENS = 256
XA_HEADS = 4
XA_HEAD_DIM = D_MODEL // XA_HEADS
D_FF = 2816
CONV_WIDTH = 3
NORM_EPS = 1e-6
SUBLN_EPS = 1e-5

kernel_name = "hybrid_diffattn_fnet_encoder"


def rmsnorm(x, g, eps=NORM_EPS):
    xf = x.astype(jnp.float32)
    y = xf * lax.rsqrt(jnp.mean(xf * xf, axis=-1, keepdims=True) + eps)
    return (y * g.astype(jnp.float32)).astype(x.dtype)


def rope_tables(S):
    half = DA_HEAD_DIM // 2
    inv_freq = ROPE_THETA ** (-jnp.arange(0, half, dtype=jnp.float32) * 2.0 / DA_HEAD_DIM)
    ang = jnp.arange(S, dtype=jnp.float32)[:, None] * inv_freq[None, :]
    return jnp.cos(ang), jnp.sin(ang)


def apply_rope(x, cos, sin):
    half = DA_HEAD_DIM // 2
    xf = x.astype(jnp.float32)
    x1, x2 = xf[..., :half], xf[..., half:]
    c = cos[:, None, None, :]
    s = sin[:, None, None, :]
    out = jnp.concatenate([x1 * c - x2 * s, x2 * c + x1 * s], axis=-1)
    return out.astype(x.dtype)


def diff_attention(xn, w_qkv, lam_q1, lam_k1, lam_q2, lam_k2, subln_g, w_o, lambda_init, cos, sin):
    B, S, _ = xn.shape
    qkv = xn @ w_qkv
    q, k, v = jnp.split(qkv, 3, axis=-1)
    q = apply_rope(q.reshape(B, S, DA_HEADS, 2, DA_HEAD_DIM), cos, sin) * (DA_HEAD_DIM ** -0.5)
    k = apply_rope(k.reshape(B, S, DA_HEADS, 2, DA_HEAD_DIM), cos, sin)
    v = v.reshape(B, S, DA_HEADS, 2 * DA_HEAD_DIM)
    f32 = jnp.float32
    lam = (jnp.exp(jnp.sum(lam_q1.astype(f32) * lam_k1.astype(f32)))
           - jnp.exp(jnp.sum(lam_q2.astype(f32) * lam_k2.astype(f32)))
           + lambda_init)
    nb = S // Q_BLOCK
    qb = q.reshape(B, nb, Q_BLOCK, DA_HEADS, 2, DA_HEAD_DIM).transpose(1, 0, 2, 3, 4, 5)

    def block(qblk):
        s = jnp.einsum("bqhcd,bkhcd->bchqk", qblk, k).astype(f32)
        p = jax.nn.softmax(s, axis=-1)
        a = p[:, 0] - lam * p[:, 1]
        return jnp.einsum("bhqk,bkhe->bqhe", a.astype(v.dtype), v)

    o = lax.map(block, qb)
    o = o.transpose(1, 0, 2, 3, 4).reshape(B, S, DA_HEADS, 2 * DA_HEAD_DIM)
    o = rmsnorm(o, subln_g, SUBLN_EPS) * (1.0 - lambda_init)
    return o.reshape(B, S, D_MODEL) @ w_o


def fourier_mix(xn, w_in, w_out):
    B, S, _ = xn.shape
    u = (xn @ w_in).reshape(B, S, FNET_GROUPS, FNET_GROUP_DIM)
    f = jnp.fft.fft2(u.astype(jnp.float32), axes=(1, 3), norm="ortho").real
    return f.astype(xn.dtype).reshape(B, S, D_MODEL) @ w_out


def cross_attention(xn, memn, w_q, w_kv, w_o):
    B, S, _ = xn.shape
    M = memn.shape[1]
    q = (xn @ w_q).reshape(B, S, XA_HEADS, XA_HEAD_DIM) * (XA_HEAD_DIM ** -0.5)
    kv = (memn @ w_kv).reshape(B, M, 2, XA_HEADS, XA_HEAD_DIM)
    k, v = kv[:, :, 0], kv[:, :, 1]
    s = jnp.einsum("bqhd,bmhd->bhqm", q, k).astype(jnp.float32)
    p = jax.nn.softmax(s, axis=-1).astype(v.dtype)
    o = jnp.einsum("bhqm,bmhd->bqhd", p, v).reshape(B, S, D_MODEL)
    return o @ w_o


def dwconv3(h, w, b):
    hp = jnp.pad(h, ((0, 0), (1, 1), (0, 0)))
    return hp[:, :-2] * w[0] + hp[:, 1:-1] * w[1] + hp[:, 2:] * w[2] + b


def conv_glu(xn, w_up, conv_w, conv_b, w_down):
    gate, val = jnp.split(xn @ w_up, 2, axis=-1)
    gate = dwconv3(gate, conv_w, conv_b)
    return (jax.nn.gelu(gate) * val) @ w_down


def trunk(x, mem, norm_mix_g, norm_xattn_g, norm_mem_g, norm_ffn_g, final_norm_g,
          attn_w_qkv, attn_lambda_q1, attn_lambda_k1, attn_lambda_q2, attn_lambda_k2,
          attn_subln_g, attn_w_o, fnet_w_in, fnet_w_out,
          xattn_w_q, xattn_w_kv, xattn_w_o,
          ffn_w_up, ffn_conv_w, ffn_conv_b, ffn_w_down):
    S = x.shape[1]
    cos, sin = rope_tables(S)
    for i in range(DEPTH):
        h = rmsnorm(x, norm_mix_g[i])
        j = i // N_MIXERS
        if i % N_MIXERS == 0:
            lambda_init = 0.8 - 0.6 * math.exp(-0.3 * i)
            x = x + diff_attention(h, attn_w_qkv[j], attn_lambda_q1[j], attn_lambda_k1[j],
                                   attn_lambda_q2[j], attn_lambda_k2[j], attn_subln_g[j],
                                   attn_w_o[j], lambda_init, cos, sin)
        else:
            x = x + fourier_mix(h, fnet_w_in[j], fnet_w_out[j])
        x = x + cross_attention(rmsnorm(x, norm_xattn_g[i]), rmsnorm(mem, norm_mem_g[i]),
                                xattn_w_q[i], xattn_w_kv[i], xattn_w_o[i])
        x = x + conv_glu(rmsnorm(x, norm_ffn_g[i]), ffn_w_up[i], ffn_conv_w[i],
                         ffn_conv_b[i], ffn_w_down[i])
    return rmsnorm(x, final_norm_g)


def setup_inputs(seed: int = 0) -> dict:
    key = jax.random.key(seed)
    ks = jax.random.split(key, 28)
    D, F = D_MODEL, D_FF

    def w(k, shape, fan_in):
        return jax.random.normal(k, shape, jnp.float32) * (fan_in ** -0.5)

    def gain(k, shape):
        return 1.0 + 0.05 * jax.random.normal(k, shape, jnp.float32)

    return {
        "x_prompt": jax.random.normal(ks[0], (BATCH, SEQ, D), jnp.float32),
        "x_sample": jax.random.normal(ks[1], (DEC_BATCH, DEC_SEQ, D), jnp.float32),
        "mem_prompt": jax.random.normal(ks[2], (BATCH, MEM_TOKENS, D), jnp.float32),
        "mem_sample": jax.random.normal(ks[3], (DEC_BATCH, MEM_TOKENS, D), jnp.float32),
        "norm_mix_g": gain(ks[4], (DEPTH, D)),
        "norm_xattn_g": gain(ks[5], (DEPTH, D)),
        "norm_mem_g": gain(ks[6], (DEPTH, D)),
        "norm_ffn_g": gain(ks[7], (DEPTH, D)),
        "final_norm_g": gain(ks[8], (D,)),
        "attn_w_qkv": w(ks[9], (N_ATTN_LAYERS, D, 3 * D), D),
        "attn_lambda_q1": 0.1 * jax.random.normal(ks[10], (N_ATTN_LAYERS, DA_HEAD_DIM), jnp.float32),
        "attn_lambda_k1": 0.1 * jax.random.normal(ks[11], (N_ATTN_LAYERS, DA_HEAD_DIM), jnp.float32),
        "attn_lambda_q2": 0.1 * jax.random.normal(ks[12], (N_ATTN_LAYERS, DA_HEAD_DIM), jnp.float32),
        "attn_lambda_k2": 0.1 * jax.random.normal(ks[13], (N_ATTN_LAYERS, DA_HEAD_DIM), jnp.float32),
        "attn_subln_g": gain(ks[14], (N_ATTN_LAYERS, 2 * DA_HEAD_DIM)),
        "attn_w_o": w(ks[15], (N_ATTN_LAYERS, D, D), D),
        "fnet_w_in": w(ks[16], (N_FNET_LAYERS, D, D), D),
        "fnet_w_out": w(ks[17], (N_FNET_LAYERS, D, D), D),
        "xattn_w_q": w(ks[18], (DEPTH, D, D), D),
        "xattn_w_kv": w(ks[19], (DEPTH, D, 2 * D), D),
        "xattn_w_o": w(ks[20], (DEPTH, D, D), D),
        "ffn_w_up": w(ks[21], (DEPTH, D, 2 * F), D),
        "ffn_conv_w": w(ks[22], (DEPTH, CONV_WIDTH, F), CONV_WIDTH),
        "ffn_conv_b": 0.02 * jax.random.normal(ks[23], (DEPTH, F), jnp.float32),
        "ffn_w_down": w(ks[24], (DEPTH, F, D), F),
    }


def reference(x_prompt, x_sample, mem_prompt, mem_sample,
              norm_mix_g, norm_xattn_g, norm_mem_g, norm_ffn_g, final_norm_g,
              attn_w_qkv, attn_lambda_q1, attn_lambda_k1, attn_lambda_q2, attn_lambda_k2,
              attn_subln_g, attn_w_o, fnet_w_in, fnet_w_out,
              xattn_w_q, xattn_w_kv, xattn_w_o,
              ffn_w_up, ffn_conv_w, ffn_conv_b, ffn_w_down):
    weights = (norm_mix_g, norm_xattn_g, norm_mem_g, norm_ffn_g, final_norm_g,
               attn_w_qkv, attn_lambda_q1, attn_lambda_k1, attn_lambda_q2, attn_lambda_k2,
               attn_subln_g, attn_w_o, fnet_w_in, fnet_w_out,
               xattn_w_q, xattn_w_kv, xattn_w_o,
               ffn_w_up, ffn_conv_w, ffn_conv_b, ffn_w_down)
    y_prompt = trunk(x_prompt, mem_prompt, *weights)
    y_sample = trunk(x_sample, mem_sample, *weights)
    return (y_prompt, y_sample)
```

```cpp
#include <hip/hip_runtime.h>
#include <hip/hip_cooperative_groups.h>
#include <cstdio>
#include <cstdint>
namespace cg = cooperative_groups;

#ifndef MK_COOP
#define MK_COOP 1
#endif

#define LAS __attribute__((address_space(3)))
#define DI __device__ __forceinline__
#define LAUNDER_V(x) asm volatile("" : "+v"(x))
#define LAUNDER_S(x) asm volatile("" : "+s"(x))
#define GAS __attribute__((address_space(1)))
#define LAUNDER_P(x) do { asm volatile("" : "+s"(x)); x = (decltype(x))(GAS unsigned char*)(unsigned char*)(x); } while (0)
typedef unsigned short bf16_t;
typedef short bf16x8 __attribute__((ext_vector_type(8)));
typedef float f32x2 __attribute__((ext_vector_type(2)));
typedef float f32x4 __attribute__((ext_vector_type(4)));
typedef float f32x16 __attribute__((ext_vector_type(16)));
typedef unsigned u32x2 __attribute__((ext_vector_type(2)));
typedef unsigned u32x4 __attribute__((ext_vector_type(4)));
typedef __bf16 bf2_t __attribute__((ext_vector_type(2)));

DI unsigned pkbf(float lo, float hi) { f32x2 v = {lo, hi}; return __builtin_bit_cast(unsigned, __builtin_convertvector(v, bf2_t)); }
DI float ldf(const float* p) { return *(const GAS float*)p; }
DI void stf(float* p, float v) { *(GAS float*)p = v; }
DI void sth(bf16_t* p, bf16_t v) { *(GAS bf16_t*)p = v; }
DI float bflo(unsigned u) { return __uint_as_float(u << 16); }
DI float bfhi(unsigned u) { return __uint_as_float(u & 0xffff0000u); }

DI float xsum32(float v) { auto r = __builtin_amdgcn_permlane32_swap(__float_as_uint(v), __float_as_uint(v), false, false); return __uint_as_float(r[0]) + __uint_as_float(r[1]); }
DI float xmax32(float v) { auto r = __builtin_amdgcn_permlane32_swap(__float_as_uint(v), __float_as_uint(v), false, false); return fmaxf(__uint_as_float(r[0]), __uint_as_float(r[1])); }
#define XSWZ(v, pat) __uint_as_float(__builtin_amdgcn_ds_swizzle(__float_as_uint(v), (pat)))

constexpr int D = 1024, TP = 65536, TS = 16384, T = TP + TS, SP = 4096, SS = 2048, FF = 2816, NMEMR = 6144;
constexpr int HALF_ROWS = 40960;
constexpr int NPH = 24;
constexpr int LDS_BYTES = 147456;
constexpr size_t MiB = 1024 * 1024;
constexpr size_t W_QK = 0, W_V = 4 * MiB, W_O = 6 * MiB, W_XQ = 8 * MiB, W_XK = 12 * MiB, W_XV = 16 * MiB, W_XO = 20 * MiB, W_FO = 24 * MiB, W_AB = 26 * MiB;
constexpr size_t WFFN = (size_t)FF * D * 2;
constexpr size_t W_G = 28 * MiB, W_VAL = W_G + 2 * WFFN, W_D = W_VAL + 2 * WFFN;
constexpr size_t ROPE_C = 61 * MiB, ROPE_S = ROPE_C + 512 * 1024, SSP_OFF = 62 * MiB, MSSP_OFF = 67 * MiB, TAB_OFF = MSSP_OFF + 512 * 1024;
constexpr size_t MEMB_OFF = 68 * MiB, KMEM_OFF = 80 * MiB, VMT_OFF = 104 * MiB, XB_OFF = 128 * MiB, BIG = 288 * MiB;
constexpr size_t QK_OFF = BIG, VT_OFF = BIG + 320 * MiB, O_OFF = BIG + 480 * MiB, QX_OFF = BIG;
constexpr size_t U_OFF = BIG, GATE_OFF = BIG + 440 * MiB;
constexpr size_t ACATP_OFF = BIG, ACATS_OFF = BIG + 132 * MiB, FB_OFF = O_OFF;
constexpr size_t COSP_OFF = BIG + 166 * MiB, SINP_OFF = BIG + 184 * MiB, COSS_OFF = BIG + 200 * MiB, SINS_OFF = BIG + 205 * MiB;
constexpr size_t PP_OFF = BIG + 210 * MiB, QP_OFF = BIG + 248 * MiB, PS_OFF = BIG + 282 * MiB, QS_OFF = BIG + 293 * MiB;
constexpr size_t WS_NEED = BIG + 660 * MiB;
constexpr size_t SSQ_STRIDE = 0;

struct Params { const float* in[25]; float* out; unsigned char* ws; int ph_lo, ph_hi; };

namespace pg8 {
constexpr int BM = 256, BK = 64, HALF = 128, HTB = HALF * BK * 2, STAGE_BYTES = 8 * HTB, NXCD = 8, WGM = 8;
DI int lds_byte(int r, int c) { const int st = (r >> 4) * 2 + (c >> 5), rr = r & 15, cc = c & 31, ob = rr * 64 + cc * 2; return st * 1024 + (ob ^ (((ob >> 9) & 1) << 5)); }
DI void stage_rc(int b, int& R, int& C) { const int st = b / 1024, sb = b % 1024, swz = sb ^ (((sb >> 9) & 1) << 5); R = (st >> 1) * 16 + swz / 64; C = (st & 1) * 32 + (swz % 64) / 2; }
DI int perm32(int rho) { const int n = rho >> 4, i = rho & 15; return 8 * (i >> 2) + 4 * n + (i & 3); }
struct Unit { int pm, pn, arow; };
struct Gemm { const bf16_t* A; const bf16_t* Bt; int M, N, K; };
struct StaticOrder {
    int nM, nN, nwg, G, c, rowmode;
    DI void init(int M, int N, int G_, int c_, int rm_ = 0) { nM = M / BM; nN = N / BM; nwg = nM * nN; G = G_; c = c_; rowmode = rm_; }
    DI bool next(int i, Unit& u) const {
        const long L = (long)i * G + c; if (L >= nwg) return false;
        int wgid = (int)L; { const int q = nwg / NXCD, r = nwg % NXCD, xcd = wgid % NXCD, off = wgid / NXCD; wgid = (xcd < r ? xcd * (q + 1) : r * (q + 1) + (xcd - r) * q) + off; }
        const int nig = WGM * nN, gid = wgid / nig, fm = gid * WGM, gsz = (nM - fm) < WGM ? (nM - fm) : WGM;
        u.pm = fm + ((wgid % nig) % gsz); u.pn = (wgid % nig) / gsz;
        if (rowmode == 0) u.arow = u.pm * 256;
        else { const int a = 254 * u.pm; u.arow = a < (T - 256) ? a : (T - 256); }
        return true;
    }
};
template <class Epi, class Sched>
DI void gemm_phase(LAS unsigned char* lds, const Gemm g, const Sched& S, const Epi& E, const int tid) {
    const int wid = __builtin_amdgcn_readfirstlane(tid >> 6), lane = tid & 63, wr = wid >> 2, wc = wid & 3, fr = lane & 15, fq = lane >> 4;
    const int K = g.K, nt = K / BK;
    unsigned voffA[2], voffB[2];
#pragma unroll
    for (int i = 0; i < 2; ++i) { int R, C; stage_rc(tid * 16 + i * 8192, R, C); const int Rb = Epi::PERM ? ((R & ~31) + perm32(R & 31)) : R;
        voffA[i] = (unsigned)(R * K + C) * 2u; voffB[i] = (unsigned)(Rb * K + C) * 2u; }
    const size_t kstep = (size_t)(BK * 2);
    const size_t hstep = (size_t)HALF * K * 2;
    const size_t tstep = 2 * hstep;
    const unsigned ldsw = (unsigned)wid * 1024u;
    const int aoff = lds_byte(wr * 64 + fr, fq * 8), boff = lds_byte(wc * 32 + fr, fq * 8);
#define PG8_SA(b, h) (((b) * 2 + (h)) * HTB)
#define PG8_SB(b, h) ((4 + (b) * 2 + (h)) * HTB)
#define PG8_STAGE(bufoff, gbase, voff) do { _Pragma("unroll") for (int _i = 0; _i < 2; ++_i) \
        __builtin_amdgcn_global_load_lds((const unsigned*)((const char*)(gbase) + (voff)[_i]), (LAS unsigned*)(lds + (bufoff) + ldsw + _i * 8192), 16, 0, 0); } while (0)
#define PG8_LDA(dst, b, h) do { _Pragma("unroll") for (int m = 0; m < 4; ++m) _Pragma("unroll") for (int k = 0; k < 2; ++k) dst[m][k] = *(const LAS bf16x8*)(lds + PG8_SA(b, h) + aoff + m * 2048 + k * 1024); } while (0)
#define PG8_LDB(dst, b, h) do { _Pragma("unroll") for (int n = 0; n < 2; ++n) _Pragma("unroll") for (int k = 0; k < 2; ++k) dst[n][k] = *(const LAS bf16x8*)(lds + PG8_SB(b, h) + boff + n * 2048 + k * 1024); } while (0)
#define PG8_MMA(ai, bj, At, Bt) do { __builtin_amdgcn_s_setprio(1); _Pragma("unroll") for (int m = 0; m < 4; ++m) _Pragma("unroll") for (int n = 0; n < 2; ++n) _Pragma("unroll") for (int k = 0; k < 2; ++k) \
        acc[ai][bj][m][n] = __builtin_amdgcn_mfma_f32_16x16x32_bf16(Bt[n][k], At[m][k], acc[ai][bj][m][n], 0, 0, 0); __builtin_amdgcn_s_setprio(0); } while (0)
#define PG8_WAIT_V(n) asm volatile("s_waitcnt vmcnt(" #n ")" ::: "memory")
#define PG8_WAIT_L(n) asm volatile("s_waitcnt lgkmcnt(" #n ")" ::: "memory")
#define PG8_BAR __builtin_amdgcn_s_barrier()
#define PG8_SCHED __builtin_amdgcn_sched_barrier(0)
    Unit cur, nxt; int ui = 0;
    if (!S.next(0, cur)) return;
    f32x4 acc[2][2][4][2];
#pragma unroll
    for (int a = 0; a < 2; ++a)
#pragma unroll
        for (int b = 0; b < 2; ++b)
#pragma unroll
            for (int m = 0; m < 4; ++m)
#pragma unroll
                for (int n = 0; n < 2; ++n) acc[a][b][m][n] = (f32x4){0.f, 0.f, 0.f, 0.f};
    bf16x8 At[4][2], B0[2][2], B1[2][2];
    const char* cA = (const char*)g.A + (size_t)cur.arow * K * 2; const char* cB = (const char*)g.Bt + (size_t)cur.pn * tstep;
    PG8_STAGE(PG8_SB(0, 0), cB, voffB); PG8_STAGE(PG8_SB(0, 1), cB + hstep, voffB); PG8_STAGE(PG8_SA(0, 0), cA, voffA); PG8_STAGE(PG8_SA(0, 1), cA + hstep, voffA);
    if (wr == 1) PG8_BAR;
    PG8_WAIT_V(2); PG8_BAR;
    PG8_STAGE(PG8_SB(1, 0), cB + kstep, voffB); PG8_STAGE(PG8_SA(1, 0), cA + kstep, voffA); PG8_STAGE(PG8_SB(1, 1), cB + hstep + kstep, voffB);
    PG8_WAIT_V(6); PG8_BAR;
    for (;;) {
        const bool has_next = S.next(ui + 1, nxt);
        const char* nA = has_next ? (const char*)g.A + (size_t)nxt.arow * K * 2 : cA; const char* nB = has_next ? (const char*)g.Bt + (size_t)nxt.pn * tstep : cB;
        for (int t = 0; t < nt; t += 2) {
            const bool last = (t == nt - 2);
            const char* a1 = cA + (size_t)(t + 1) * kstep;
            const char* a2 = last ? nA : cA + (size_t)(t + 2) * kstep; const char* b2 = last ? nB : cB + (size_t)(t + 2) * kstep;
            const char* a3 = a2 + kstep; const char* b3 = b2 + kstep;
            PG8_LDB(B0, 0, 0); PG8_LDB(B1, 0, 1); PG8_SCHED; PG8_LDA(At, 0, 0); PG8_STAGE(PG8_SA(1, 1), a1 + hstep, voffA);
            PG8_WAIT_V(8); PG8_WAIT_L(0); PG8_BAR; PG8_MMA(0, 0, At, B0); PG8_MMA(0, 1, At, B1); PG8_BAR; PG8_SCHED;
            PG8_LDA(At, 0, 1); PG8_STAGE(PG8_SB(0, 0), b2, voffB); PG8_STAGE(PG8_SB(0, 1), b2 + hstep, voffB); PG8_STAGE(PG8_SA(0, 0), a2, voffA);
            PG8_WAIT_V(8); PG8_WAIT_L(0); PG8_BAR; PG8_MMA(1, 0, At, B0); PG8_MMA(1, 1, At, B1); PG8_BAR; PG8_SCHED;
            PG8_LDB(B0, 1, 0); PG8_LDB(B1, 1, 1); PG8_SCHED; PG8_LDA(At, 1, 0); PG8_STAGE(PG8_SA(0, 1), a2 + hstep, voffA);
            PG8_WAIT_V(8); PG8_WAIT_L(0); PG8_BAR; PG8_MMA(0, 0, At, B0); PG8_MMA(0, 1, At, B1); PG8_BAR; PG8_SCHED;
            PG8_LDA(At, 1, 1); PG8_STAGE(PG8_SB(1, 0), b3, voffB); PG8_STAGE(PG8_SB(1, 1), b3 + hstep, voffB); PG8_STAGE(PG8_SA(1, 0), a3, voffA);
            PG8_WAIT_V(8); PG8_WAIT_L(0); PG8_BAR; PG8_MMA(1, 0, At, B0); PG8_MMA(1, 1, At, B1); PG8_BAR; PG8_SCHED;
        }
        if constexpr (Epi::ALIGN) { if (wr == 0) PG8_BAR; }
        E(acc, cur, wr, wc, fr, fq);
        if (!has_next) break;
#pragma unroll
        for (int a = 0; a < 2; ++a)
#pragma unroll
            for (int b = 0; b < 2; ++b)
#pragma unroll
                for (int m = 0; m < 4; ++m)
#pragma unroll
                    for (int n = 0; n < 2; ++n) acc[a][b][m][n] = (f32x4){0.f, 0.f, 0.f, 0.f};
        cur = nxt; cA = nA; cB = nB; ++ui;
        if constexpr (Epi::ALIGN) { if (wr == 1) PG8_BAR; }
    }
    PG8_WAIT_V(0);
    if constexpr (!Epi::ALIGN) { if (wr == 0) PG8_BAR; }
    PG8_BAR;
#undef PG8_SA
#undef PG8_SB
#undef PG8_STAGE
#undef PG8_LDA
#undef PG8_LDB
#undef PG8_MMA
#undef PG8_WAIT_V
#undef PG8_WAIT_L
#undef PG8_BAR
#undef PG8_SCHED
}
}
using pg8::Unit;
typedef f32x4 AccT[2][2][4][2];

DI float rowscale16(const float* ssp, int r, float eps) {
    const GAS f32x4* p = (const GAS f32x4*)(ssp + (size_t)r * 16);
    const f32x4 a = p[0], b = p[1], c = p[2], d = p[3];
    const float s = ((a[0] + a[1]) + (a[2] + a[3])) + ((b[0] + b[1]) + (b[2] + b[3])) + ((c[0] + c[1]) + (c[2] + c[3])) + ((d[0] + d[1]) + (d[2] + d[3]));
    return __builtin_amdgcn_rsqf(s * (1.0f / 1024.0f) + eps);
}
DI u32x4 pack8(const f32x4 a, const f32x4 b) { u32x4 w; w.x = pkbf(a[0], a[1]); w.y = pkbf(a[2], a[3]); w.z = pkbf(b[0], b[1]); w.w = pkbf(b[2], b[3]); return w; }
#define EPI_ROWS(rs, ssq, rb) float rs[2][4]; { f32x4 q_[2][4]; _Pragma("unroll") for (int ai_ = 0; ai_ < 2; ++ai_) _Pragma("unroll") for (int m_ = 0; m_ < 4; ++m_) \
        q_[ai_][m_] = *(const GAS f32x4*)((ssq) + (size_t)(u.arow + ai_ * 128 + wr * 64 + m_ * 16 + fr + (rb)) * 16 + 4 * fq); \
    _Pragma("unroll") for (int ai_ = 0; ai_ < 2; ++ai_) _Pragma("unroll") for (int m_ = 0; m_ < 4; ++m_) { \
        float p_ = (q_[ai_][m_][0] + q_[ai_][m_][1]) + (q_[ai_][m_][2] + q_[ai_][m_][3]); p_ += XSWZ(p_, 0x401F); p_ = xsum32(p_); \
        rs[ai_][m_] = __builtin_amdgcn_rsqf(p_ * (1.0f / 1024.0f) + 1e-6f); } }
#define EPI_COLS(s0, s1, ssq, c0) f32x4 s0, s1; { float v_[8]; _Pragma("unroll") for (int t_ = 0; t_ < 8; ++t_) v_[t_] = ldf((ssq) + (size_t)((c0) + t_) * 16 + fr); \
    _Pragma("unroll") for (int t_ = 0; t_ < 8; ++t_) { float p_ = v_[t_]; p_ += XSWZ(p_, 0x041F); p_ += XSWZ(p_, 0x081F); p_ += XSWZ(p_, 0x101F); p_ += XSWZ(p_, 0x201F); \
        const float r_ = __builtin_amdgcn_rsqf(p_ * (1.0f / 1024.0f) + 1e-6f); if (t_ < 4) s0[t_ & 3] = r_; else s1[t_ & 3] = r_; } }
struct EpiQK {
    static constexpr bool PERM = true; static constexpr bool ALIGN = true;
    bf16_t* O; const float* ssp; const float* cs; const float* sn; float qscale;
    DI void operator()(const AccT& acc, const Unit& u, int wr, int wc, int fr, int fq) const {
        const float hs = (u.pn < 4) ? qscale : 1.0f;
        EPI_ROWS(rs, ssp, 0);
#pragma unroll
        for (int ai = 0; ai < 2; ++ai) {
#pragma unroll
            for (int m = 0; m < 4; ++m) {
                const int r = u.arow + ai * 128 + wr * 64 + m * 16 + fr;
                const float sc = rs[ai][m] * hs;
                const int s = (r < TP) ? (r & (SP - 1)) : (r & (SS - 1));
                const GAS f32x4* cp = (const GAS f32x4*)(cs + s * 32 + 8 * fq); const GAS f32x4* sp = (const GAS f32x4*)(sn + s * 32 + 8 * fq);
                f32x4 o1[2], o2[2];
#pragma unroll
                for (int n = 0; n < 2; ++n) { const f32x4 c = cp[n], sv = sp[n]; const f32x4 x1 = acc[ai][0][m][n] * sc, x2 = acc[ai][1][m][n] * sc;
                    o1[n] = x1 * c - x2 * sv; o2[n] = x2 * c + x1 * sv; }
                bf16_t* op = O + (size_t)r * 2048 + u.pn * 256 + wc * 64 + 8 * fq;
                *(GAS u32x4*)op = pack8(o1[0], o1[1]); *(GAS u32x4*)(op + 32) = pack8(o2[0], o2[1]);
            }
            __builtin_amdgcn_sched_barrier(0);
        }
    }
};
struct EpiCol {
    static constexpr bool PERM = true; static constexpr bool ALIGN = true;
    bf16_t* O; size_t ld; const float* ssp;
    DI void operator()(const AccT& acc, const Unit& u, int wr, int wc, int fr, int fq) const {
#pragma unroll
        for (int bj = 0; bj < 2; ++bj) {
            const int c0 = u.pn * 256 + bj * 128 + wc * 32 + 8 * fq;
            EPI_COLS(s0, s1, ssp, c0);
#pragma unroll
            for (int ai = 0; ai < 2; ++ai)
#pragma unroll
                for (int m = 0; m < 4; ++m) { const int r = u.arow + ai * 128 + wr * 64 + m * 16 + fr;
                    __builtin_nontemporal_store(pack8(acc[ai][bj][m][0] * s0, acc[ai][bj][m][1] * s1), (GAS u32x4*)(O + (size_t)r * ld + c0)); }
        }
    }
};
struct EpiFZ {
    static constexpr bool PERM = true; static constexpr bool ALIGN = true;
    bf16_t* AP; bf16_t* AS; const float* ssp;
    DI void operator()(const AccT& acc, const Unit& u, int wr, int wc, int fr, int fq) const {
#pragma unroll
        for (int bj = 0; bj < 2; ++bj) {
            const int c0 = u.pn * 256 + bj * 128 + wc * 32 + 8 * fq;
            EPI_COLS(s0, s1, ssp, c0);
            bf16_t* base; int b, s, S;
            size_t nrt; if (c0 < TP) { base = AP; b = c0 >> 12; s = c0 & (SP - 1); S = SP; nrt = 8448; } else { const int c1 = c0 - TP; base = AS; b = c1 >> 11; s = c1 & (SS - 1); S = SS; nrt = 4352; }
#pragma unroll
            for (int ai = 0; ai < 2; ++ai)
#pragma unroll
                for (int m = 0; m < 4; ++m) { const int r = u.arow + ai * 128 + wr * 64 + m * 16 + fr;
                    const int g = r >> 8, jj = r & 255, part = jj > 128 ? 1 : 0, mm = jj - 128 * part;
                    const size_t row = (size_t)part * nrt + (size_t)(b * 516 + g * 129 + mm);
                    *(GAS u32x4*)(base + row * S + s) = pack8(acc[ai][bj][m][0] * s0, acc[ai][bj][m][1] * s1); }
        }
    }
};
struct EpiRow {
    static constexpr bool PERM = true; static constexpr bool ALIGN = true;
    bf16_t* O; int ldo; const float* ssp; float scale; int rbase;
    DI void operator()(const AccT& acc, const Unit& u, int wr, int wc, int fr, int fq) const {
        EPI_ROWS(rs, ssp, rbase);
#pragma unroll
        for (int ai = 0; ai < 2; ++ai)
#pragma unroll
            for (int m = 0; m < 4; ++m) { const int r = u.arow + ai * 128 + wr * 64 + m * 16 + fr;
                const float sc = rs[ai][m] * scale;
                bf16_t* op = O + (size_t)r * ldo + u.pn * 256 + wc * 32 + 8 * fq;
#pragma unroll
                for (int bj = 0; bj < 2; ++bj) __builtin_nontemporal_store(pack8(acc[ai][bj][m][0] * sc, acc[ai][bj][m][1] * sc), (GAS u32x4*)(op + bj * 128)); }
    }
};
struct EpiRes {
    static constexpr bool PERM = true; static constexpr bool ALIGN = true;
    bf16_t* XB; float* ssp;
    DI void operator()(const AccT& acc, const Unit& u, int wr, int wc, int fr, int fq) const {
#pragma unroll
        for (int ai = 0; ai < 2; ++ai) {
            u32x4 rv[4][2];
#pragma unroll
            for (int m = 0; m < 4; ++m)
#pragma unroll
                for (int bj = 0; bj < 2; ++bj) rv[m][bj] = *(const GAS u32x4*)(XB + (size_t)(u.arow + ai * 128 + wr * 64 + m * 16 + fr) * D + u.pn * 256 + bj * 128 + wc * 32 + 8 * fq);
#pragma unroll
            for (int m = 0; m < 4; ++m) { const int r = u.arow + ai * 128 + wr * 64 + m * 16 + fr;
                float ss = 0.f;
#pragma unroll
                for (int bj = 0; bj < 2; ++bj) { const int col = u.pn * 256 + bj * 128 + wc * 32 + 8 * fq;
                    const u32x4 q = rv[m][bj];
                    const f32x4 a = {bflo(q.x), bfhi(q.x), bflo(q.y), bfhi(q.y)}, b = {bflo(q.z), bfhi(q.z), bflo(q.w), bfhi(q.w)};
                    const f32x4 v0 = acc[ai][bj][m][0] + a, v1 = acc[ai][bj][m][1] + b;
                    *(GAS u32x4*)(XB + (size_t)r * D + col) = pack8(v0, v1);
                    ss += (v0[0] * v0[0] + v0[1] * v0[1]) + (v0[2] * v0[2] + v0[3] * v0[3]) + (v1[0] * v1[0] + v1[1] * v1[1]) + (v1[2] * v1[2] + v1[3] * v1[3]); }
                ss += XSWZ(ss, 0x401F); ss = xsum32(ss);
                if (fq == 0) stf(ssp + (size_t)r * 16 + u.pn * 4 + wc, ss); }
            __builtin_amdgcn_sched_barrier(0);
        }
    }
};
DI float gelu_tanh(float x) {
    const float z = 1.5957691216f * (x + 0.044715f * x * x * x);
    return x * __builtin_amdgcn_rcpf(1.0f + __builtin_amdgcn_exp2f(-1.4426950409f * z));
}
DI float dpp_f(float oldv, float src, const int ctrl_sel) {
    const int o = __float_as_int(oldv), s = __float_as_int(src); int r;
    if (ctrl_sel == 0) r = __builtin_amdgcn_update_dpp(o, s, 0x111, 0xf, 0xf, false);
    else if (ctrl_sel == 1) r = __builtin_amdgcn_update_dpp(o, s, 0x101, 0xf, 0xf, false);
    else if (ctrl_sel == 2) r = __builtin_amdgcn_update_dpp(o, s, 0x121, 0xf, 0xf, false);
    else r = __builtin_amdgcn_update_dpp(o, s, 0x12F, 0xf, 0xf, false);
    return __int_as_float(r);
}
struct EpiUp {
    static constexpr bool PERM = true; static constexpr bool ALIGN = true;
    bf16_t* U; const float* ssp; const float* cw; const float* cb; LAS float* ex;
    DI void operator()(AccT& acc, const Unit& u, int wr, int wc, int fr, int fq) const {
        EPI_ROWS(rs, ssp, 0);
#pragma unroll
        for (int ai = 0; ai < 2; ++ai)
#pragma unroll
            for (int m = 0; m < 4; ++m)
#pragma unroll
                for (int n = 0; n < 2; ++n) acc[ai][0][m][n] = acc[ai][0][m][n] * rs[ai][m];
        const int colw = wc * 32 + 8 * fq;
#pragma unroll
        for (int ai = 0; ai < 2; ++ai) { const int blk = 2 * ai + wr;
            if (fr == 0) {
#pragma unroll
                for (int n = 0; n < 2; ++n) *(LAS f32x4*)(ex + (blk * 2 + 0) * 128 + colw + 4 * n) = acc[ai][0][0][n]; }
            if (fr == 15) {
#pragma unroll
                for (int n = 0; n < 2; ++n) *(LAS f32x4*)(ex + (blk * 2 + 1) * 128 + colw + 4 * n) = acc[ai][0][3][n]; }
        }
        asm volatile("s_waitcnt lgkmcnt(0)" ::: "memory"); __builtin_amdgcn_s_barrier(); asm volatile("" ::: "memory");
#pragma unroll
        for (int n = 0; n < 2; ++n) {
            const int f0 = u.pn * 128 + colw + 4 * n;
            const f32x4 w0 = *(const GAS f32x4*)(cw + f0), w1 = *(const GAS f32x4*)(cw + FF + f0), w2 = *(const GAS f32x4*)(cw + 2 * FF + f0), bb = *(const GAS f32x4*)(cb + f0);
#pragma unroll
            for (int ai = 0; ai < 2; ++ai) { const int blk = 2 * ai + wr;
                f32x4 pe = {0.f, 0.f, 0.f, 0.f}, ne = {0.f, 0.f, 0.f, 0.f};
                if (blk > 0) pe = *(const LAS f32x4*)(ex + ((blk - 1) * 2 + 1) * 128 + colw + 4 * n);
                if (blk < 3) ne = *(const LAS f32x4*)(ex + ((blk + 1) * 2 + 0) * 128 + colw + 4 * n);
#pragma unroll
                for (int m = 0; m < 4; ++m) {
                    const int local = ai * 128 + wr * 64 + m * 16 + fr, ra = u.arow + local;
                    const int S = (ra < TP) ? SP : SS, s = ra & (S - 1);
                    const float fm = (s > 0) ? 1.0f : 0.0f, fn = (s < S - 1) ? 1.0f : 0.0f;
                    const bool valid = (local > 0 || ra == 0) && (local < 255 || ra == T - 1);
                    f32x4 cv;
#pragma unroll
                    for (int j = 0; j < 4; ++j) {
                        const float g = acc[ai][0][m][n][j];
                        const float oldu = (m > 0) ? dpp_f(0.f, acc[ai][0][m > 0 ? m - 1 : 0][n][j], 2) : pe[j];
                        const float oldd = (m < 3) ? dpp_f(0.f, acc[ai][0][m < 3 ? m + 1 : 3][n][j], 3) : ne[j];
                        const float up = dpp_f(oldu, g, 0), dn = dpp_f(oldd, g, 1);
                        cv[j] = (fm * up) * w0[j] + (g * w1[j] + ((fn * dn) * w2[j] + bb[j])); }
                    const f32x4 tt = cv * (cv * cv * (-0.1029432397f) + (-2.3022081820f));
                    const f32x4 xv = cv * (acc[ai][1][m][n] * rs[ai][m]);
                    f32x4 o;
#pragma unroll
                    for (int j = 0; j < 4; ++j) o[j] = xv[j] * __builtin_amdgcn_rcpf(1.0f + __builtin_amdgcn_exp2f(tt[j]));
                    u32x2 w; w.x = pkbf(o[0], o[1]); w.y = pkbf(o[2], o[3]);
                    if (valid) *(GAS u32x2*)(U + (size_t)ra * FF + f0) = w; }
            }
        }
        asm volatile("s_waitcnt lgkmcnt(0)" ::: "memory");
    }
};
struct EpiDFT {
    static constexpr bool PERM = true; static constexpr bool ALIGN = true;
    bf16_t* O; int ldo;
    DI void operator()(const AccT& acc, const Unit& u, int wr, int wc, int fr, int fq) const {
#pragma unroll
        for (int ai = 0; ai < 2; ++ai)
#pragma unroll
            for (int m = 0; m < 4; ++m) { const int r = u.arow + ai * 128 + wr * 64 + m * 16 + fr;
                bf16_t* op = O + (size_t)r * ldo + u.pn * 256 + wc * 32 + 8 * fq;
#pragma unroll
                for (int bj = 0; bj < 2; ++bj) *(GAS u32x4*)(op + bj * 128) = pack8(acc[ai][bj][m][0], acc[ai][bj][m][1]); }
    }
};
DI void dft_combine(LAS unsigned char* lds, const bf16_t* P, int ldp, const bf16_t* Q, int ldq, bf16_t* FB, int S, int nb, float scale, int bid, int G, int tid) {
    LAS float* y1 = (LAS float*)lds; LAS float* y2 = y1 + 129 * 65;
    const int nkb = S >> 7, nitems = nb * 4 * nkb;
    for (int it = bid; it < nitems; it += G) {
        const int kb = it % nkb, bg = it / nkb, b = bg >> 2, g = bg & 3, k0 = kb * 64;
        __syncthreads();
        for (int idx = tid; idx < 129 * 64; idx += 512) { const int m = idx >> 6, kk = idx & 63; const size_t R = (size_t)(b * 516 + g * 129 + m);
            const float pv = __uint_as_float((unsigned)(*(const GAS bf16_t*)(P + R * ldp + k0 + kk)) << 16), qv = __uint_as_float((unsigned)(*(const GAS bf16_t*)(Q + R * ldq + k0 + kk)) << 16);
            y1[m * 65 + kk] = (pv - qv) * scale; y2[m * 65 + kk] = (pv + qv) * scale; }
        __syncthreads();
        const int tsel = tid >> 8, c = tid & 255, mi = (c <= 128) ? c : 256 - c;
        const LAS float* src = ((c <= 128) == (tsel == 0)) ? y1 : y2;
        for (int kk = 0; kk < 64; ++kk) { const int k = k0 + kk, tok = tsel ? ((S - k) & (S - 1)) : k;
            const float v = src[mi * 65 + kk];
            if (!(tsel && k == 0)) sth(FB + ((size_t)(b * S + tok)) * D + g * 256 + c, (bf16_t)(pkbf(v, 0.f) & 0xffffu)); }
    }
    for (int it = bid; it < nb * 4; it += G) {
        const int b = it >> 2, g = it & 3;
        if (tid < 256) { const int c = tid, mi = (c <= 128) ? c : 256 - c; const size_t R = (size_t)(b * 516 + g * 129 + mi);
            const float v = __uint_as_float((unsigned)(*(const GAS bf16_t*)(P + R * ldp + (S >> 1))) << 16) * scale;
            sth(FB + ((size_t)(b * S + (S >> 1))) * D + g * 256 + c, (bf16_t)(pkbf(v, 0.f) & 0xffffu)); }
    }
    __syncthreads();
}

DI int swap23(int x) { return (x & ~12) | ((x & 4) << 1) | ((x & 8) >> 1); }
template <int DK, int KCOLS, bool DIFF>
DI void attn_unit(LAS unsigned char* lds, const bf16_t* Q, int q_ld, const bf16_t* K, int k_ld, const bf16_t* Vt, size_t vt_ld, int nkeys,
                  bf16_t* Oout, float lam, const float* subg, const int tid) {
    constexpr int KROWB = KCOLS * 2 + 16, KCH = KCOLS / 8, KBYTES = 64 * KROWB, VROWB = 144, VBYTES = 128 * VROWB, BUFB = KBYTES + VBYTES;
    constexpr int NKL = KCH * 64 / 512, NS = DK / 16, EXOFF = 2 * BUFB;
    static_assert(EXOFF + (DIFF ? 65536 : 0) <= LDS_BYTES, "attention LDS");
    const int wid = __builtin_amdgcn_readfirstlane(tid >> 6), lane = tid & 63, n = lane & 31, hh = lane >> 5;
    const int qs = DIFF ? (wid >> 1) : wid, c = DIFF ? (wid & 1) : 0;
    bf16x8 qf[NS];
    { const bf16_t* qrow = Q + (size_t)(qs * 32 + n) * q_ld + c * DK + 8 * hh;
#pragma unroll
      for (int s = 0; s < NS; ++s) qf[s] = *(const GAS bf16x8*)(qrow + 16 * s); }
    f32x16 o[4];
    float mrun = -1e30f, lrun = 0.f;
#pragma unroll
    for (int e = 0; e < 4; ++e)
#pragma unroll
        for (int i = 0; i < 16; ++i) o[e][i] = 0.f;
    u32x4 kreg[2][NKL], vreg[2][2];
    const int stid = DIFF ? ((wid >> 2) * 512 + (tid & 255)) : tid;
    constexpr int SSTR = DIFF ? 256 : 512;
#define AT_GLOAD(t, P) do { _Pragma("unroll") for (int i_ = 0; i_ < NKL; ++i_) { const int ci = stid + SSTR * i_, row = ci / KCH, col = ci % KCH; \
            kreg[P][i_] = *(const GAS u32x4*)(K + (size_t)((t) * 64 + row) * k_ld + col * 8); } \
        _Pragma("unroll") for (int i_ = 0; i_ < 2; ++i_) { const int ci = stid + SSTR * i_, row = ci >> 3, col = ci & 7; \
            vreg[P][i_] = *(const GAS u32x4*)(Vt + (size_t)row * vt_ld + (t) * 64 + col * 8); } } while (0)
#define AT_LSTORE_K(buf, P) do { _Pragma("unroll") for (int i_ = 0; i_ < NKL; ++i_) { const int ci = stid + SSTR * i_, row = ci / KCH, col = ci % KCH; \
            *(LAS u32x4*)(lds + (buf) * BUFB + row * KROWB + col * 16) = kreg[P][i_]; } } while (0)
#define AT_LSTORE_V(buf, P) do { _Pragma("unroll") for (int i_ = 0; i_ < 2; ++i_) { const int ci = stid + SSTR * i_, row = ci >> 3, col = ci & 7; \
            *(LAS u32x4*)(lds + (buf) * BUFB + KBYTES + row * VROWB + col * 16) = vreg[P][i_]; } } while (0)
    AT_GLOAD(0, 0); AT_LSTORE_K(0, 0); AT_LSTORE_V(0, 0); __syncthreads();
#define AT_LBAR do { asm volatile("s_waitcnt lgkmcnt(0)" ::: "memory"); __builtin_amdgcn_s_barrier(); asm volatile("" ::: "memory"); } while (0)
    const int nt = nkeys >> 6;
    const int krow0 = swap23(n);
    if constexpr (DIFF) {
        if (nt > 1) AT_GLOAD(1, 1);
        if (wid >= 4) AT_LBAR;
#pragma unroll 1
        for (int t0 = 0; t0 < nt; t0 += 2) {
#pragma unroll
        for (int par = 0; par < 2; ++par) {
            const int t = t0 + par;
            const int buf = par;
            if (t + 2 < nt) AT_GLOAD(t + 2, par);
            const LAS unsigned char* kb_ = lds + buf * BUFB; const LAS unsigned char* vb_ = kb_ + KBYTES;
            f32x16 sa[2];
            {
                const LAS unsigned char* kp0 = kb_ + krow0 * KROWB + c * DK * 2 + 16 * hh; const LAS unsigned char* kp1 = kp0 + 32 * KROWB;
                bf16x8 ka[NS], kc[NS];
#pragma unroll
                for (int s = 0; s < NS; ++s) ka[s] = *(const LAS bf16x8*)(kp0 + 32 * s);
#pragma unroll
                for (int i = 0; i < 16; ++i) { sa[0][i] = 0.f; sa[1][i] = 0.f; }
                __builtin_amdgcn_sched_barrier(0);
#pragma unroll
                for (int s = 0; s < NS; ++s) kc[s] = *(const LAS bf16x8*)(kp1 + 32 * s);
#pragma unroll
                for (int s = 0; s < NS; ++s) sa[0] = __builtin_amdgcn_mfma_f32_32x32x16_bf16(ka[s], qf[s], sa[0], 0, 0, 0);
                __builtin_amdgcn_sched_barrier(0);
#pragma unroll
                for (int s = 0; s < NS; ++s) sa[1] = __builtin_amdgcn_mfma_f32_32x32x16_bf16(kc[s], qf[s], sa[1], 0, 0, 0);
            }
            float mx = sa[0][0];
#pragma unroll
            for (int kb = 0; kb < 2; ++kb)
#pragma unroll
                for (int i = 0; i < 16; ++i) mx = fmaxf(mx, sa[kb][i]);
            mx = xmax32(mx);
            const float mnew = fmaxf(mrun, mx);
            const float alpha = __builtin_amdgcn_exp2f(mrun - mnew);
            mrun = mnew;
            float rs = 0.f;
            bf16x8 pf[2][2];
#pragma unroll
            for (int i = 0; i < 16; ++i) { const float pv = __builtin_amdgcn_exp2f(sa[0][i] - mnew); sa[0][i] = pv; rs += pv; }
#pragma unroll
            for (int s2 = 0; s2 < 2; ++s2) {
                u32x4 pw; pw.x = pkbf(sa[0][8 * s2 + 0], sa[0][8 * s2 + 1]); pw.y = pkbf(sa[0][8 * s2 + 2], sa[0][8 * s2 + 3]);
                pw.z = pkbf(sa[0][8 * s2 + 4], sa[0][8 * s2 + 5]); pw.w = pkbf(sa[0][8 * s2 + 6], sa[0][8 * s2 + 7]);
                pf[0][s2] = __builtin_bit_cast(bf16x8, pw); }
            if (t + 1 < nt) AT_LSTORE_K(buf ^ 1, par ^ 1);
            AT_LBAR;
            if (t + 1 < nt) AT_LSTORE_V(buf ^ 1, par ^ 1);
#pragma unroll
            for (int i = 0; i < 16; ++i) { const float pv = __builtin_amdgcn_exp2f(sa[1][i] - mnew); sa[1][i] = pv; rs += pv; }
#pragma unroll
            for (int s2 = 0; s2 < 2; ++s2) {
                u32x4 pw; pw.x = pkbf(sa[1][8 * s2 + 0], sa[1][8 * s2 + 1]); pw.y = pkbf(sa[1][8 * s2 + 2], sa[1][8 * s2 + 3]);
                pw.z = pkbf(sa[1][8 * s2 + 4], sa[1][8 * s2 + 5]); pw.w = pkbf(sa[1][8 * s2 + 6], sa[1][8 * s2 + 7]);
                pf[1][s2] = __builtin_bit_cast(bf16x8, pw); }
            lrun = lrun * alpha + rs;
            if (__builtin_amdgcn_ballot_w64(alpha != 1.0f) != 0ull) {
#pragma unroll
                for (int e = 0; e < 4; ++e) o[e] = o[e] * alpha;
            }
            {
                const LAS unsigned char* vp = vb_ + n * VROWB + 16 * hh;
                bf16x8 va[4], vc[4];
#pragma unroll
                for (int e = 0; e < 4; ++e) va[e] = *(const LAS bf16x8*)(vp + e * 32 * VROWB);
                __builtin_amdgcn_sched_barrier(0);
#pragma unroll
                for (int e = 0; e < 4; ++e) vc[e] = *(const LAS bf16x8*)(vp + e * 32 * VROWB + 32);
#pragma unroll
                for (int e = 0; e < 4; ++e) o[e] = __builtin_amdgcn_mfma_f32_32x32x16_bf16(va[e], pf[0][0], o[e], 0, 0, 0);
                __builtin_amdgcn_sched_barrier(0);
#pragma unroll
                for (int e = 0; e < 4; ++e) va[e] = *(const LAS bf16x8*)(vp + e * 32 * VROWB + 64);
#pragma unroll
                for (int e = 0; e < 4; ++e) o[e] = __builtin_amdgcn_mfma_f32_32x32x16_bf16(vc[e], pf[0][1], o[e], 0, 0, 0);
                __builtin_amdgcn_sched_barrier(0);
#pragma unroll
                for (int e = 0; e < 4; ++e) vc[e] = *(const LAS bf16x8*)(vp + e * 32 * VROWB + 96);
#pragma unroll
                for (int e = 0; e < 4; ++e) o[e] = __builtin_amdgcn_mfma_f32_32x32x16_bf16(va[e], pf[1][0], o[e], 0, 0, 0);
                __builtin_amdgcn_sched_barrier(0);
#pragma unroll
                for (int e = 0; e < 4; ++e) o[e] = __builtin_amdgcn_mfma_f32_32x32x16_bf16(vc[e], pf[1][1], o[e], 0, 0, 0);
            }
            AT_LBAR;
        }
        }
        if (wid < 4) AT_LBAR;
    } else {
#pragma unroll 1
        for (int t = 0; t < nt; ++t) {
            const int buf = t & 1;
            if (t + 1 < nt) { AT_GLOAD(t + 1, 0); AT_LSTORE_K(buf ^ 1, 0); AT_LSTORE_V(buf ^ 1, 0); }
            const LAS unsigned char* kb_ = lds + buf * BUFB; const LAS unsigned char* vb_ = kb_ + KBYTES;
#pragma unroll
            for (int kb = 0; kb < 2; ++kb) {
                f32x16 sa;
#pragma unroll
                for (int i = 0; i < 16; ++i) sa[i] = 0.f;
                const LAS unsigned char* kp = kb_ + (kb * 32 + krow0) * KROWB + c * DK * 2 + 16 * hh;
#pragma unroll
                for (int s = 0; s < NS; ++s) { const bf16x8 kf = *(const LAS bf16x8*)(kp + 32 * s); sa = __builtin_amdgcn_mfma_f32_32x32x16_bf16(kf, qf[s], sa, 0, 0, 0);
                    if (NS > 4 && (s & 3) == 3) __builtin_amdgcn_sched_barrier(0); }
                float mx = sa[0];
#pragma unroll
                for (int i = 1; i < 16; ++i) mx = fmaxf(mx, sa[i]);
                mx = xmax32(mx);
                const float mnew = fmaxf(mrun, mx);
                const float alpha = __builtin_amdgcn_exp2f(mrun - mnew);
                mrun = mnew;
                float rs = 0.f;
#pragma unroll
                for (int i = 0; i < 16; ++i) { const float pv = __builtin_amdgcn_exp2f(sa[i] - mnew); sa[i] = pv; rs += pv; }
                lrun = lrun * alpha + rs;
                if (__builtin_amdgcn_ballot_w64(alpha != 1.0f) != 0ull) {
#pragma unroll
                    for (int e = 0; e < 4; ++e) o[e] = o[e] * alpha;
                }
#pragma unroll
                for (int s2 = 0; s2 < 2; ++s2) {
                    u32x4 pw; pw.x = pkbf(sa[8 * s2 + 0], sa[8 * s2 + 1]); pw.y = pkbf(sa[8 * s2 + 2], sa[8 * s2 + 3]);
                    pw.z = pkbf(sa[8 * s2 + 4], sa[8 * s2 + 5]); pw.w = pkbf(sa[8 * s2 + 6], sa[8 * s2 + 7]);
                    const bf16x8 pf = __builtin_bit_cast(bf16x8, pw);
                    const LAS unsigned char* vp = vb_ + n * VROWB + (kb * 32 + 16 * s2 + 8 * hh) * 2;
#pragma unroll
                    for (int e = 0; e < 4; ++e) { const bf16x8 vf = *(const LAS bf16x8*)(vp + e * 32 * VROWB); o[e] = __builtin_amdgcn_mfma_f32_32x32x16_bf16(vf, pf, o[e], 0, 0, 0); }
                }
                __builtin_amdgcn_sched_barrier(0);
            }
            __syncthreads();
        }
    }
#undef AT_LBAR
#undef AT_GLOAD
#undef AT_LSTORE_K
#undef AT_LSTORE_V
    bf16_t* orow = Oout + (size_t)(qs * 32 + n) * D;
    const float ltot = xsum32(lrun);
    if constexpr (DIFF) {
        LAS float* ex = (LAS float*)(lds + EXOFF) + qs * 4096 + lane;
        if (c == 1) { const float i2 = lam / ltot;
#pragma unroll
            for (int e = 0; e < 4; ++e)
#pragma unroll
                for (int i = 0; i < 16; ++i) ex[(e * 16 + i) * 64] = o[e][i] * i2; }
        __syncthreads();
        if (c == 0) {
            const float i1 = 1.0f / ltot;
            float ss = 0.f;
#pragma unroll
            for (int e = 0; e < 4; ++e)
#pragma unroll
                for (int i = 0; i < 16; ++i) { const float v = o[e][i] * i1 - ex[(e * 16 + i) * 64]; o[e][i] = v; ss += v * v; }
            ss = xsum32(ss);
            const float rn = __builtin_amdgcn_rsqf(ss * (1.0f / 128.0f) + 1e-5f) * 0.8f;
#pragma unroll
            for (int e = 0; e < 4; ++e)
#pragma unroll
                for (int g4 = 0; g4 < 4; ++g4) { const int e0 = e * 32 + 8 * g4 + 4 * hh; const f32x4 gv = *(const GAS f32x4*)(subg + e0);
                    u32x2 w; w.x = pkbf(o[e][4 * g4] * rn * gv[0], o[e][4 * g4 + 1] * rn * gv[1]); w.y = pkbf(o[e][4 * g4 + 2] * rn * gv[2], o[e][4 * g4 + 3] * rn * gv[3]);
                    *(GAS u32x2*)(orow + e0) = w; }
        }
    } else {
        const float i1 = 1.0f / ltot;
#pragma unroll
        for (int e = 0; e < 4; ++e)
#pragma unroll
            for (int g4 = 0; g4 < 4; ++g4) { const int e0 = e * 32 + 8 * g4 + 4 * hh;
                u32x2 w; w.x = pkbf(o[e][4 * g4] * i1, o[e][4 * g4 + 1] * i1); w.y = pkbf(o[e][4 * g4 + 2] * i1, o[e][4 * g4 + 3] * i1);
                *(GAS u32x2*)(orow + e0) = w; }
    }
    __syncthreads();
}


DI void wconv(bf16_t* dst, const float* src, int ld, int coff, int N, int K, const float* g, int perm, int gtid, int gsz) {
    const int items = N * (K / 8);
    for (int id = gtid; id < items; id += gsz) {
        const int n = id % N, kg = id / N;
        int col = n;
        if (perm == 1) { const int p = n & 255; col = (n & ~255) + 64 * ((p & 127) >> 5) + 32 * (p >> 7) + (p & 31); }
        else if (perm == 2) { const int p = n & 255, pn = n >> 8; col = (p < 128) ? (128 * pn + p) : (FF + 128 * pn + (p - 128)); }
        const float* s = src + (size_t)(kg * 8) * ld + coff + col;
        float v[8];
#pragma unroll
        for (int i = 0; i < 8; ++i) v[i] = ldf(s + (size_t)i * ld) * (g ? ldf(g + kg * 8 + i) : 1.0f);
        u32x4 w; w.x = pkbf(v[0], v[1]); w.y = pkbf(v[2], v[3]); w.z = pkbf(v[4], v[5]); w.w = pkbf(v[6], v[7]);
        *(GAS u32x4*)(dst + (size_t)n * K + kg * 8) = w;
    }
}
DI void act_conv(const float* x, bf16_t* xb, float* ssq, int rows, int bid, int nb, int tid) {
    const int lane = tid & 63;
    for (int r = bid * 8 + (tid >> 6); r < rows; r += nb * 8) {
        float ss = 0.f;
#pragma unroll
        for (int h = 0; h < 2; ++h) { const int c0 = h * 512 + lane * 8;
            const f32x4 a = __builtin_nontemporal_load((const GAS f32x4*)(x + (size_t)r * D + c0)), b = __builtin_nontemporal_load((const GAS f32x4*)(x + (size_t)r * D + c0 + 4));
            ss += (a[0] * a[0] + a[1] * a[1]) + (a[2] * a[2] + a[3] * a[3]) + (b[0] * b[0] + b[1] * b[1]) + (b[2] * b[2] + b[3] * b[3]);
            *(GAS u32x4*)(xb + (size_t)r * D + c0) = pack8(a, b); }
        ss += XSWZ(ss, 0x041F); ss += XSWZ(ss, 0x081F); ss += XSWZ(ss, 0x101F); ss += XSWZ(ss, 0x201F); ss += XSWZ(ss, 0x401F); ss = xsum32(ss);
        if (lane < 16) stf(ssq + (size_t)r * 16 + lane, (lane == 0) ? ss : 0.0f);
    }
}
DI void zero_fill(void* p, size_t bytes, int gtid, int gsz) {
    GAS u32x4* q = (GAS u32x4*)p; const size_t n = bytes / 16; unsigned zz = 0u; LAUNDER_V(zz); const u32x4 z = {zz, zz, zz, zz};
    for (size_t i = gtid; i < n; i += gsz) q[i] = z;
}

enum { T_QK = 0, T_COL, T_FZ, T_ROW, T_RES, T_GLU, T_DFT };
struct Job { int type; const bf16_t* A; const bf16_t* Bt; int M, N, K, rot; int l, h; };

#define XB_TMO      128
#define XB_XCNT(j)  (256  + 64 * (j))
#define XB_XSUB(j)  (1280 + 64 * (j))
#define XB_XGEN(j)  (2304 + 64 * (j))
#define XB_TOP      3328
#define XB_TOPGEN   3392
#define XCD_BAR_WORDS 3456
#define XB_SPIN_CAP (1u << 20)
DI unsigned xb_ld(unsigned* p)              { return __hip_atomic_load(p, __ATOMIC_RELAXED, __HIP_MEMORY_SCOPE_AGENT); }
DI unsigned xb_add(unsigned* p, unsigned v) { return __hip_atomic_fetch_add(p, v, __ATOMIC_RELAXED, __HIP_MEMORY_SCOPE_AGENT); }
DI unsigned xb_xcc_id() { return (unsigned)__builtin_amdgcn_s_getreg((3 << 11) | 20) & 0xFu; }
#define XB_SPIN(cond, bar) do { unsigned _sp = 0; while (cond) { __builtin_amdgcn_s_sleep(1); \
    if ((++_sp & 255u) == 0u) { if (xb_ld(&(bar)[XB_TMO])) break; if (_sp > XB_SPIN_CAP) { atomicAdd(&(bar)[XB_TMO], 1u); break; } } } } while (0)
struct XcdBarrier { unsigned* bar; unsigned x; volatile LAS unsigned* st; };
DI XcdBarrier xcd_barrier_post(unsigned* bar, volatile LAS unsigned* st) {
    XcdBarrier b; b.bar = bar; b.x = xb_xcc_id(); b.st = st;
    if (threadIdx.x == 0) (void)xb_add(&bar[XB_XCNT(b.x)], 1u);
    return b;
}
DI void xcd_barrier_complete(unsigned* bar, unsigned x, unsigned& nloc, unsigned& nx) {
    const unsigned G = gridDim.x * gridDim.y * gridDim.z;
    unsigned sum, cnt, mine, sp = 0u;
    for (;;) {
        sum = 0u; cnt = 0u; mine = 0u;
#pragma unroll
        for (unsigned j = 0; j < 16; ++j) { const unsigned c = xb_ld(&bar[XB_XCNT(j)]); sum += c; cnt += (c > 0u) ? 1u : 0u; mine = (j == x) ? c : mine; }
        if (sum == G) break;
        __builtin_amdgcn_s_sleep(1);
        if ((++sp & 255u) == 0u) { if (xb_ld(&bar[XB_TMO])) break; if (sp > XB_SPIN_CAP) { atomicAdd(&bar[XB_TMO], 1u); break; } }
    }
    nloc = mine > 0u ? mine : 1u; nx = cnt > 0u ? cnt : 1u;
}
DI void xcd_barrier(const XcdBarrier& b) {
    asm volatile("s_waitcnt vmcnt(0)" ::: "memory");
    __syncthreads();
    if (threadIdx.x == 0) {
        unsigned* bar = b.bar;
        __builtin_amdgcn_s_waitcnt(0);
        unsigned nloc = b.st[0], nx = b.st[1];
        if (nloc == 0u) { xcd_barrier_complete(bar, b.x, nloc, nx); b.st[0] = nloc; b.st[1] = nx; }
        const unsigned old = xb_add(&bar[XB_XSUB(b.x)], 1u);
        const unsigned gen = old / nloc;
        if (old + 1u == (gen + 1u) * nloc) {
            __builtin_amdgcn_fence(__ATOMIC_RELEASE, "agent");
            asm volatile("s_waitcnt vmcnt(0)" ::: "memory");
            const unsigned og = xb_add(&bar[XB_TOP], 1u);
            const unsigned tg = og / nx;
            if (og + 1u == (tg + 1u) * nx) xb_add(&bar[XB_TOPGEN], 1u);
            else XB_SPIN(xb_ld(&bar[XB_TOPGEN]) == tg, bar);
            __builtin_amdgcn_fence(__ATOMIC_ACQUIRE, "agent");
            xb_add(&bar[XB_XGEN(b.x)], 1u);
            asm volatile("s_waitcnt vmcnt(0)" ::: "memory");
        } else {
            XB_SPIN(xb_ld(&bar[XB_XGEN(b.x)]) == gen, bar);
            __builtin_amdgcn_fence(__ATOMIC_ACQUIRE, "agent");
            asm volatile("s_waitcnt vmcnt(0)" ::: "memory");
        }
    }
    __syncthreads();
}
constexpr size_t BAR_OFF = TAB_OFF + 32 * 1024;

__global__ void __launch_bounds__(512, 2) mk_fwd(Params p) {
    extern __shared__ __attribute__((aligned(16))) unsigned char smem[];
    LAS unsigned char* lds = (LAS unsigned char*)smem;
    XcdBarrier xbar; xbar.bar = (unsigned*)(p.ws + BAR_OFF); xbar.x = 0; xbar.st = (volatile LAS unsigned*)(lds + LDS_BYTES - 64);
    if (p.ph_hi - p.ph_lo > 1) {
        if (threadIdx.x == 0) { xbar.st[0] = 0u; xbar.st[1] = 0u; }
        __syncthreads();
        xbar = xcd_barrier_post((unsigned*)(p.ws + BAR_OFF), (volatile LAS unsigned*)(lds + LDS_BYTES - 64));
    }
    if (p.ph_lo == 0) {
        const int ph = 0;
        unsigned char* ws = p.ws; float* X = p.out; int tid = threadIdx.x, bid = blockIdx.x;
        LAUNDER_P(ws); LAUNDER_P(X); asm volatile("" : "+v"(tid)); asm volatile("" : "+s"(bid));
        const int G = gridDim.x, gtid = bid * 512 + tid, gsz = G * 512;
        bf16_t* const XB = (bf16_t*)(ws + XB_OFF); float* const SSPp = (float*)(ws + SSP_OFF); float* const MSSP = (float*)(ws + MSSP_OFF);
        bf16_t* const MEMB = (bf16_t*)(ws + MEMB_OFF); float* const TAB = (float*)(ws + TAB_OFF);
            LAS float* tab = (LAS float*)lds;
            for (int j = tid; j < 4096; j += 512) { const float v = cospif((float)j * (1.0f / 2048.0f)); tab[j] = v; if (bid == 0) stf(TAB + j, v); }
            __syncthreads();
            const float* g_mix = p.in[4]; const float* g_xa = p.in[5]; const float* g_mem = p.in[6]; const float* g_ffn = p.in[7];
            wconv((bf16_t*)(ws + W_QK), p.in[9], 3072, 0, 2048, D, g_mix, 1, gtid, gsz);
            wconv((bf16_t*)(ws + W_V), p.in[9], 3072, 2048, 1024, D, g_mix, 0, gtid, gsz);
            wconv((bf16_t*)(ws + W_O), p.in[15], 1024, 0, 1024, D, nullptr, 0, gtid, gsz);
            wconv((bf16_t*)(ws + W_FO), p.in[17], 1024, 0, 1024, D, nullptr, 0, gtid, gsz);
            for (int l = 0; l < 2; ++l) {
                wconv((bf16_t*)(ws + W_XQ + l * 2 * MiB), p.in[18] + (size_t)l * D * D, 1024, 0, 1024, D, g_xa + l * D, 0, gtid, gsz);
                wconv((bf16_t*)(ws + W_XK + l * 2 * MiB), p.in[19] + (size_t)l * D * 2048, 2048, 0, 1024, D, g_mem + l * D, 0, gtid, gsz);
                wconv((bf16_t*)(ws + W_XV + l * 2 * MiB), p.in[19] + (size_t)l * D * 2048, 2048, 1024, 1024, D, g_mem + l * D, 0, gtid, gsz);
                wconv((bf16_t*)(ws + W_XO + l * 2 * MiB), p.in[20] + (size_t)l * D * D, 1024, 0, 1024, D, nullptr, 0, gtid, gsz);
                wconv((bf16_t*)(ws + W_G + l * 2 * WFFN), p.in[21] + (size_t)l * D * 2 * FF, 2 * FF, 0, 2 * FF, D, g_ffn + l * D, 2, gtid, gsz);
                wconv((bf16_t*)(ws + W_D + l * WFFN), p.in[24] + (size_t)l * FF * D, 1024, 0, 1024, FF, nullptr, 0, gtid, gsz);
            }
            { const float* win = p.in[16]; bf16_t* wab = (bf16_t*)(ws + W_AB);
              for (int id = gtid; id < 1024 * 128; id += gsz) {
                  const int n = id & 1023, kg = id >> 10, gq = n >> 8, jj = n & 255, issin = jj > 128 ? 1 : 0, mm = jj - 128 * issin;
                  float a[8];
#pragma unroll
                  for (int i = 0; i < 8; ++i) a[i] = 0.f;
                  const float* wp = win + (size_t)(kg * 8) * D + gq * 256;
                  for (int c = 0; c < 256; ++c) {
                      float tv = tab[(16 * mm * c + 1024 * issin) & 4095]; if (issin) tv = -tv;
#pragma unroll
                      for (int i = 0; i < 8; ++i) a[i] += ldf(wp + (size_t)i * D + c) * tv;
                  }
                  const float* gm1 = g_mix + D + kg * 8;
                  u32x4 w; w.x = pkbf(a[0] * gm1[0], a[1] * gm1[1]); w.y = pkbf(a[2] * gm1[2], a[3] * gm1[3]); w.z = pkbf(a[4] * gm1[4], a[5] * gm1[5]); w.w = pkbf(a[6] * gm1[6], a[7] * gm1[7]);
                  *(GAS u32x4*)(wab + (size_t)n * D + kg * 8) = w;
              } }
            act_conv(p.in[0], XB, SSPp, TP, bid, G, tid);
            act_conv(p.in[1], XB + (size_t)TP * D, SSPp + (size_t)TP * 16, TS, bid, G, tid);
            act_conv(p.in[2], MEMB, MSSP, 4096, bid, G, tid);
            act_conv(p.in[3], MEMB + (size_t)4096 * D, MSSP + 4096 * 16, 2048, bid, G, tid);
            { float* cs = (float*)(ws + ROPE_C); float* sn = (float*)(ws + ROPE_S);
              for (int id = gtid; id < 4096 * 32; id += gsz) { const int s = id >> 5, i = id & 31;
                  const float inv = exp2f(-(float)(2 * i) * (13.287712379549449f / 64.0f)); const float ang = (float)s * inv;
                  float sv, cv; sincosf(ang, &sv, &cv); stf(cs + id, cv); stf(sn + id, sv); } }
            __syncthreads();
        if (p.ph_hi < 0) cg::this_grid().sync();
        if (1 < p.ph_hi) xcd_barrier(xbar);
    }
    for (int ph = (p.ph_lo < 1 ? 1 : p.ph_lo); ph < p.ph_hi; ++ph) {
        if ((ph >= 8 && ph <= 10) || (ph >= 19 && ph <= 21)) continue;
        unsigned char* ws = p.ws; float* X = p.out; int bid = blockIdx.x;
        LAUNDER_P(ws); LAUNDER_P(X); asm volatile("" : "+s"(bid));
        const int G = gridDim.x, gsz = G * 512;
        bf16_t* const XB = (bf16_t*)(ws + XB_OFF); float* const SSPp = (float*)(ws + SSP_OFF); float* const MSSP = (float*)(ws + MSSP_OFF);
        bf16_t* const MEMB = (bf16_t*)(ws + MEMB_OFF); float* const TAB = (float*)(ws + TAB_OFF);
        if (ph == 2) {
            int tid = threadIdx.x; LAUNDER_V(tid); LAUNDER_P(ws);
            const float* lq1 = p.in[10]; const float* lk1 = p.in[11]; const float* lq2 = p.in[12]; const float* lk2 = p.in[13];
            float s1 = 0.f, s2 = 0.f;
            for (int i = 0; i < 64; ++i) { s1 += lq1[i] * lk1[i]; s2 += lq2[i] * lk2[i]; }
            const float lam = expf(s1) - expf(s2) + 0.2f;
            const bf16_t* QK = (const bf16_t*)(ws + QK_OFF); const bf16_t* VT = (const bf16_t*)(ws + VT_OFF); bf16_t* Ob = (bf16_t*)(ws + O_OFF);
            const int xcd = bid & 7, slot = bid >> 3;
            for (int i = 0; i < 20; ++i) {
                int b, h, qb, S, tok0;
                if (i < 16) { const int bh = i * 8 + xcd; qb = slot; b = bh >> 3; h = bh & 7; S = SP; tok0 = b * SP; }
                else { const int bh = (i - 16) * 16 + xcd * 2 + (slot >> 4); qb = slot & 15; b = bh >> 3; h = bh & 7; S = SS; tok0 = TP + b * SS; }
                attn_unit<64, 128, true>(lds, QK + (size_t)(tok0 + qb * 128) * 2048 + h * 128, 2048, QK + (size_t)tok0 * 2048 + 1024 + h * 128, 2048,
                                 VT + (size_t)(h * 128) * T + tok0, (size_t)T, S, Ob + (size_t)(tok0 + qb * 128) * D + h * 128, lam, p.in[14], tid);
            }
        } else if (ph == 5 || ph == 16) {
            int tid = threadIdx.x; LAUNDER_V(tid); LAUNDER_P(ws);
            const int l = (ph == 5) ? 0 : 1;
            const bf16_t* QX = (const bf16_t*)(ws + QX_OFF); const bf16_t* KM = (const bf16_t*)(ws + KMEM_OFF + l * 12 * MiB); const bf16_t* VM = (const bf16_t*)(ws + VMT_OFF + l * 12 * MiB);
            bf16_t* Ob = (bf16_t*)(ws + O_OFF);
            for (int i = 0; i < 10; ++i) {
                const int u = i * 256 + bid; int eh, qb, h, b, tok0, mem0;
                if (u < 2048) { eh = u & 1; qb = (u >> 1) & 15; h = (u >> 5) & 3; b = u >> 7; tok0 = b * SP; mem0 = b * 256; }
                else { const int v = u - 2048; eh = v & 1; qb = (v >> 1) & 7; h = (v >> 4) & 3; b = v >> 6; tok0 = TP + b * SS; mem0 = 4096 + b * 256; }
                attn_unit<256, 256, false>(lds, QX + (size_t)(tok0 + qb * 256) * D + h * 256, D, KM + (size_t)mem0 * D + h * 256, D,
                                  VM + (size_t)(h * 256 + eh * 128) * NMEMR + mem0, (size_t)NMEMR, 256, Ob + (size_t)(tok0 + qb * 256) * D + h * 256 + eh * 128, 0.f, nullptr, tid);
            }
        } else if (ph == 23) {
            int tid = threadIdx.x; LAUNDER_V(tid); LAUNDER_P(X); LAUNDER_P(ws);
            const float* gf = p.in[8]; const float* ss6 = (const float*)(ws + SSP_OFF + 6 * SSQ_STRIDE); const bf16_t* xbf = (const bf16_t*)(ws + XB_OFF);
            for (int r = bid * 4 + (tid >> 7); r < T; r += G * 4) {
                const int c0 = (tid & 127) * 8; const float rs = rowscale16(ss6, r, 1e-6f);
                const u32x4 q = __builtin_nontemporal_load((const GAS u32x4*)(xbf + (size_t)r * D + c0));
                const f32x4 a = {bflo(q.x), bfhi(q.x), bflo(q.y), bfhi(q.y)}, b = {bflo(q.z), bfhi(q.z), bflo(q.w), bfhi(q.w)};
                const f32x4 g0 = *(const GAS f32x4*)(gf + c0), g1 = *(const GAS f32x4*)(gf + c0 + 4);
                float* xp = X + (size_t)r * D + c0;
                *(GAS f32x4*)xp = a * rs * g0; *(GAS f32x4*)(xp + 4) = b * rs * g1;
            }
        } else {
            if (ph == 12) {
                int tid = threadIdx.x; LAUNDER_V(tid); LAUNDER_P(ws); const int gtid = bid * 512 + tid;
                LAS float* tab = (LAS float*)lds;
#pragma unroll
                for (int i = 0; i < 8; ++i) tab[tid + 512 * i] = ldf(TAB + tid + 512 * i);
                __syncthreads();
                int msk = 4095; LAUNDER_S(msk);
                for (int tb = 0; tb < 4; ++tb) {
                    bf16_t* dst = (bf16_t*)(ws + (tb == 0 ? COSP_OFF : tb == 1 ? SINP_OFF : tb == 2 ? COSS_OFF : SINS_OFF));
                    const int rows = tb == 0 ? 2304 : tb == 1 ? 2048 : tb == 2 ? 1280 : 1024, lg = tb < 2 ? 9 : 8, mul = tb < 2 ? 1 : 2, off = (tb & 1) ? 1024 : 0;
                    const float sg = (tb & 1) ? -1.0f : 1.0f;
                    for (int id = gtid; id < (rows << lg); id += gsz) { const int nn = id >> lg, j0 = (id & ((1 << lg) - 1)) * 8; float v[8];
                        const int base = mul * nn * j0 + off;
#pragma unroll
                        for (int i = 0; i < 8; ++i) v[i] = sg * tab[(base + mul * nn * i) & msk];
                        u32x4 w; w.x = pkbf(v[0], v[1]); w.y = pkbf(v[2], v[3]); w.z = pkbf(v[4], v[5]); w.w = pkbf(v[6], v[7]);
                        *(GAS u32x4*)(dst + ((size_t)nn << (lg + 3)) + j0) = w; }
                }
                bf16_t* ap = (bf16_t*)(ws + ACATP_OFF); bf16_t* as = (bf16_t*)(ws + ACATS_OFF);
                for (int q = 0; q < 16 * 8; ++q) { const int b = q >> 3, g = (q >> 1) & 3, mm = (q & 1) * 128; zero_fill(ap + ((size_t)8448 + (size_t)(b * 516 + g * 129 + mm)) * SP, SP * 2, gtid, gsz); }
                for (int q = 0; q < 8 * 8; ++q) { const int b = q >> 3, g = (q >> 1) & 3, mm = (q & 1) * 128; zero_fill(as + ((size_t)4352 + (size_t)(b * 516 + g * 129 + mm)) * SS, SS * 2, gtid, gsz); }
                for (int part = 0; part < 2; ++part) {
                    zero_fill(ap + ((size_t)part * 8448 + 8256) * SP, (size_t)(8448 - 8256) * SP * 2, gtid, gsz);
                    zero_fill(as + ((size_t)part * 4352 + 4128) * SS, (size_t)(4352 - 4128) * SS * 2, gtid, gsz);
                }
                __syncthreads();
            }
            for (int j = 0; j < (ph == 24 ? 0 : 6); ++j) {
                unsigned char* wj = ws; LAUNDER_P(wj);
                const int cidx = ph <= 1 ? 0 : ph <= 4 ? 1 : ph <= 10 ? 2 : ph <= 12 ? 3 : ph <= 15 ? 4 : ph <= 21 ? 5 : 6;
                const bf16_t* const XBj = (const bf16_t*)(wj + XB_OFF); const bf16_t* const MEMBj = (const bf16_t*)(wj + MEMB_OFF);
                Job jb; jb.type = -1; jb.rot = 0; jb.l = 0; jb.h = 0; jb.K = D; jb.M = T; jb.N = D; jb.A = XBj; jb.Bt = nullptr;
                const int l = (ph >= 15) ? 1 : 0;
                if (ph == 1) {
                    if (j == 0) { jb.type = T_QK; jb.Bt = (const bf16_t*)(wj + W_QK); jb.N = 2048; }
                    else if (j == 1) { jb.type = T_COL; jb.A = (const bf16_t*)(wj + W_V); jb.Bt = XBj; jb.M = 1024; jb.N = T; jb.l = 2; }
                    else if (j < 4) { jb.type = T_ROW; jb.l = j - 2; jb.h = 2; jb.A = MEMBj; jb.Bt = (const bf16_t*)(wj + W_XK + (j - 2) * 2 * MiB); jb.M = NMEMR; jb.rot = (j - 2) * 96; }
                    else { jb.type = T_COL; jb.l = j - 4; jb.A = (const bf16_t*)(wj + W_XV + (j - 4) * 2 * MiB); jb.Bt = MEMBj; jb.M = 1024; jb.N = NMEMR; jb.rot = 192 + (j - 4) * 96; }
                } else if (j == 0 || (ph == 13 && j <= 3)) {
                    if (ph == 3) { jb.type = T_RES; jb.A = (const bf16_t*)(wj + O_OFF); jb.Bt = (const bf16_t*)(wj + W_O); jb.h = 1; }
                    else if (ph == 4 || ph == 15) { jb.type = T_ROW; jb.Bt = (const bf16_t*)(wj + W_XQ + l * 2 * MiB); jb.l = l; jb.h = 0; }
                    else if (ph == 6 || ph == 17) { jb.type = T_RES; jb.A = (const bf16_t*)(wj + O_OFF); jb.Bt = (const bf16_t*)(wj + W_XO + l * 2 * MiB); }
                    else if (ph == 7 || ph == 18) { jb.type = T_GLU; jb.l = l; jb.Bt = (const bf16_t*)(wj + W_G + l * 2 * WFFN); jb.M = 323 * 256; jb.N = 2 * FF; jb.h = 1; }
                    else if (ph == 11 || ph == 22) { jb.type = T_RES; jb.A = (const bf16_t*)(wj + U_OFF); jb.Bt = (const bf16_t*)(wj + W_D + l * WFFN); jb.K = FF; }
                    else if (ph == 12) { jb.type = T_FZ; jb.A = (const bf16_t*)(wj + W_AB); jb.Bt = XBj; jb.M = 1024; jb.N = T; }
                    else if (ph == 13) { jb.type = T_DFT; jb.l = j;
                        if (j == 0) { jb.A = (const bf16_t*)(wj + ACATP_OFF); jb.Bt = (const bf16_t*)(wj + COSP_OFF); jb.M = 8448; jb.N = 2304; jb.K = SP; }
                        else if (j == 1) { jb.A = (const bf16_t*)(wj + ACATP_OFF) + (size_t)8448 * SP; jb.Bt = (const bf16_t*)(wj + SINP_OFF); jb.M = 8448; jb.N = 2048; jb.K = SP; jb.rot = 215; }
                        else if (j == 2) { jb.A = (const bf16_t*)(wj + ACATS_OFF); jb.Bt = (const bf16_t*)(wj + COSS_OFF); jb.M = 4352; jb.N = 1280; jb.K = SS; jb.rot = 207; }
                        else { jb.A = (const bf16_t*)(wj + ACATS_OFF) + (size_t)4352 * SS; jb.Bt = (const bf16_t*)(wj + SINS_OFF); jb.M = 4352; jb.N = 1024; jb.K = SS; jb.rot = 122; } }
                    else if (ph == 14) { jb.type = T_RES; jb.A = (const bf16_t*)(wj + FB_OFF); jb.Bt = (const bf16_t*)(wj + W_FO); }
                }
                if (jb.type < 0) break;
                pg8::Gemm gm; gm.A = jb.A; gm.Bt = jb.Bt; gm.M = jb.M; gm.N = jb.N; gm.K = jb.K;
                pg8::StaticOrder So; So.init(jb.M, jb.N, G, (bid + jb.rot) % G, jb.type == T_GLU ? 1 : 0);
                if (jb.type == T_QK) { EpiQK E; unsigned char* wsl = ws; LAUNDER_P(wsl); E.O = (bf16_t*)(wsl + QK_OFF); E.ssp = (float*)(wsl + SSP_OFF + cidx * SSQ_STRIDE); E.cs = (const float*)(wsl + ROPE_C); E.sn = (const float*)(wsl + ROPE_S); E.qscale = 0.125f * 1.4426950409f;
                    { int tl = threadIdx.x; LAUNDER_V(tl); pg8::gemm_phase(lds, gm, So, E, tl); } }
                else if (jb.type == T_COL) { EpiCol E; unsigned char* wsl = ws; LAUNDER_P(wsl);
                    if (jb.l == 2) { E.O = (bf16_t*)(wsl + VT_OFF); E.ld = T; E.ssp = (float*)(wsl + SSP_OFF + cidx * SSQ_STRIDE); } else { E.O = (bf16_t*)(wsl + VMT_OFF + jb.l * 12 * MiB); E.ld = NMEMR; E.ssp = (float*)(wsl + MSSP_OFF); }
                    { int tl = threadIdx.x; LAUNDER_V(tl); pg8::gemm_phase(lds, gm, So, E, tl); } }
                else if (jb.type == T_FZ) { EpiFZ E; unsigned char* wsl = ws; LAUNDER_P(wsl); E.AP = (bf16_t*)(wsl + ACATP_OFF); E.AS = (bf16_t*)(wsl + ACATS_OFF); E.ssp = (float*)(wsl + SSP_OFF + cidx * SSQ_STRIDE); { int tl = threadIdx.x; LAUNDER_V(tl); pg8::gemm_phase(lds, gm, So, E, tl); } }
                else if (jb.type == T_ROW) { EpiRow E; unsigned char* wsl = ws; LAUNDER_P(wsl);
                    if (jb.h == 0) { E.O = (bf16_t*)(wsl + QX_OFF); E.ldo = D; E.ssp = (float*)(wsl + SSP_OFF + cidx * SSQ_STRIDE); E.scale = 0.0625f * 1.4426950409f; E.rbase = 0; }
                    else { E.O = (bf16_t*)(wsl + KMEM_OFF + jb.l * 12 * MiB); E.ldo = D; E.ssp = (float*)(wsl + MSSP_OFF); E.scale = 1.0f; E.rbase = 0; }
                    { int tl = threadIdx.x; LAUNDER_V(tl); pg8::gemm_phase(lds, gm, So, E, tl); } }
                else if (jb.type == T_RES) { EpiRes E; unsigned char* wsl = ws; LAUNDER_P(wsl); E.XB = (bf16_t*)(wsl + XB_OFF); E.ssp = (float*)(wsl + SSP_OFF + cidx * SSQ_STRIDE);
                    { int tl = threadIdx.x; LAUNDER_V(tl); pg8::gemm_phase(lds, gm, So, E, tl); } }
                else if (jb.type == T_GLU) { EpiUp E; unsigned char* wsl = ws; LAUNDER_P(wsl); E.U = (bf16_t*)(wsl + U_OFF); E.ssp = (float*)(wsl + SSP_OFF + cidx * SSQ_STRIDE); E.cw = p.in[22] + (size_t)jb.l * 3 * FF; E.cb = p.in[23] + (size_t)jb.l * FF; E.ex = (LAS float*)(lds + 131072);
                    { int tl = threadIdx.x; LAUNDER_V(tl); pg8::gemm_phase(lds, gm, So, E, tl); } }
                else { EpiDFT E; unsigned char* wsl = ws; LAUNDER_P(wsl);
                    E.O = (bf16_t*)(wsl + (jb.l == 0 ? PP_OFF : jb.l == 1 ? QP_OFF : jb.l == 2 ? PS_OFF : QS_OFF)); E.ldo = jb.N;
                    { int tl = threadIdx.x; LAUNDER_V(tl); pg8::gemm_phase(lds, gm, So, E, tl); } }
            }
            if ((ph == 13 && p.ph_hi - p.ph_lo > 1) || ph == 24) {
                if (ph == 13) xcd_barrier(xbar);
                int tid = threadIdx.x; LAUNDER_V(tid); unsigned char* wc_ = ws; LAUNDER_P(wc_);
                dft_combine(lds, (const bf16_t*)(wc_ + PP_OFF), 2304, (const bf16_t*)(wc_ + QP_OFF), 2048, (bf16_t*)(wc_ + FB_OFF), SP, 16, 1.0f / 1024.0f, bid, G, tid);
                dft_combine(lds, (const bf16_t*)(wc_ + PS_OFF), 1280, (const bf16_t*)(wc_ + QS_OFF), 1024, (bf16_t*)(wc_ + FB_OFF) + (size_t)TP * D, SS, 8, 0.0013810679f, bid, G, tid);
            }
        }
        if (ph + 1 < p.ph_hi) xcd_barrier(xbar);
    }
}

extern "C" void kernel_launch(void* const* d_in, const int* in_sizes, int n_in, void* d_out, int out_size, void* d_ws, size_t ws_size, hipStream_t stream) {
    static int grid = 0;
    if (grid == 0) {
        if (n_in != 25 || out_size != T * D || ws_size < WS_NEED) { fprintf(stderr, "kernel_launch: unexpected shapes (n_in %d out %d ws %zu need %zu)\n", n_in, out_size, ws_size, (size_t)WS_NEED); grid = -1; return; }
        if (hipFuncSetAttribute((const void*)mk_fwd, hipFuncAttributeMaxDynamicSharedMemorySize, LDS_BYTES) != hipSuccess) { fprintf(stderr, "kernel_launch: hipFuncSetAttribute failed\n"); grid = -1; return; }
        int dev = 0, cus = 0, per_cu = 0;
        (void)hipGetDevice(&dev); (void)hipDeviceGetAttribute(&cus, hipDeviceAttributeMultiprocessorCount, dev);
        (void)hipOccupancyMaxActiveBlocksPerMultiprocessor(&per_cu, (const void*)mk_fwd, 512, LDS_BYTES);
        if (per_cu < 1) fprintf(stderr, "kernel_launch: occupancy query says %d blocks per CU\n", per_cu);
        (void)hipGetLastError();
        grid = cus > 0 ? cus : 256;
        if (grid > 256) grid = 256;
    }
    if (grid < 0) return;
    Params p{};
    for (int i = 0; i < 25; ++i) p.in[i] = (const float*)d_in[i];
    p.out = (float*)d_out; p.ws = (unsigned char*)d_ws;
#if MK_COOP
    p.ph_lo = 0; p.ph_hi = NPH;
    (void)hipMemsetAsync((unsigned char*)d_ws + BAR_OFF, 0, 16384, stream);
    void* args[] = {&p};
    hipError_t e = hipLaunchCooperativeKernel((const void*)mk_fwd, dim3(grid), dim3(512), args, LDS_BYTES, stream);
    if (e != hipSuccess) fprintf(stderr, "kernel_launch: cooperative launch failed: %s (grid %d)\n", hipGetErrorString(e), grid);
#else
    for (int ph = 0; ph < NPH; ++ph) { p.ph_lo = ph; p.ph_hi = ph + 1; hipLaunchKernelGGL(mk_fwd, dim3(grid), dim3(512), LDS_BYTES, stream, p);
        if (ph == 13) { p.ph_lo = 24; p.ph_hi = 25; hipLaunchKernelGGL(mk_fwd, dim3(grid), dim3(512), LDS_BYTES, stream, p); } }
#endif
}
```

```cpp
#include <hip/hip_runtime.h>
#include <hip/hip_cooperative_groups.h>
#include <cstdio>
#include <cstdint>
namespace cg = cooperative_groups;

#ifndef MK_COOP
#define MK_COOP 1
#endif

#define LAS __attribute__((address_space(3)))
#define DI __device__ __forceinline__
#define LAUNDER_V(x) asm volatile("" : "+v"(x))
#define LAUNDER_S(x) asm volatile("" : "+s"(x))
#define GAS __attribute__((address_space(1)))
#define LAUNDER_P(x) do { asm volatile("" : "+s"(x)); x = (decltype(x))(GAS unsigned char*)(unsigned char*)(x); } while (0)
typedef unsigned short bf16_t;
typedef short bf16x8 __attribute__((ext_vector_type(8)));
typedef float f32x2 __attribute__((ext_vector_type(2)));
typedef float f32x4 __attribute__((ext_vector_type(4)));
typedef float f32x16 __attribute__((ext_vector_type(16)));
typedef unsigned u32x2 __attribute__((ext_vector_type(2)));
typedef unsigned u32x4 __attribute__((ext_vector_type(4)));
typedef __bf16 bf2_t __attribute__((ext_vector_type(2)));

DI unsigned pkbf(float lo, float hi) { f32x2 v = {lo, hi}; return __builtin_bit_cast(unsigned, __builtin_convertvector(v, bf2_t)); }
DI float ldf(const float* p) { return *(const GAS float*)p; }
DI void stf(float* p, float v) { *(GAS float*)p = v; }
DI void sth(bf16_t* p, bf16_t v) { *(GAS bf16_t*)p = v; }
DI float bflo(unsigned u) { return __uint_as_float(u << 16); }
DI float bfhi(unsigned u) { return __uint_as_float(u & 0xffff0000u); }

DI float xsum32(float v) { auto r = __builtin_amdgcn_permlane32_swap(__float_as_uint(v), __float_as_uint(v), false, false); return __uint_as_float(r[0]) + __uint_as_float(r[1]); }
DI float xmax32(float v) { auto r = __builtin_amdgcn_permlane32_swap(__float_as_uint(v), __float_as_uint(v), false, false); return fmaxf(__uint_as_float(r[0]), __uint_as_float(r[1])); }
#define XSWZ(v, pat) __uint_as_float(__builtin_amdgcn_ds_swizzle(__float_as_uint(v), (pat)))

constexpr int D = 1024, TP = 65536, TS = 16384, T = TP + TS, SP = 4096, SS = 2048, FF = 2816, NMEMR = 6144;
constexpr int HALF_ROWS = 40960;
constexpr int NPH = 24;
constexpr int LDS_BYTES = 147456;
constexpr size_t MiB = 1024 * 1024;
constexpr size_t W_QK = 0, W_V = 4 * MiB, W_O = 6 * MiB, W_XQ = 8 * MiB, W_XK = 12 * MiB, W_XV = 16 * MiB, W_XO = 20 * MiB, W_FO = 24 * MiB, W_AB = 26 * MiB;
constexpr size_t WFFN = (size_t)FF * D * 2;
constexpr size_t W_G = 28 * MiB, W_VAL = W_G + 2 * WFFN, W_D = W_VAL + 2 * WFFN;
constexpr size_t ROPE_C = 61 * MiB, ROPE_S = ROPE_C + 512 * 1024, SSP_OFF = 62 * MiB, MSSP_OFF = 67 * MiB, TAB_OFF = MSSP_OFF + 512 * 1024;
constexpr size_t MEMB_OFF = 68 * MiB, KMEM_OFF = 80 * MiB, VMT_OFF = 104 * MiB, XB_OFF = 128 * MiB, BIG = 288 * MiB;
constexpr size_t QK_OFF = BIG, VT_OFF = BIG + 320 * MiB, O_OFF = BIG + 480 * MiB, QX_OFF = BIG;
constexpr size_t U_OFF = BIG, GATE_OFF = BIG + 440 * MiB;
constexpr size_t ACATP_OFF = BIG, ACATS_OFF = BIG + 132 * MiB, FB_OFF = O_OFF;
constexpr size_t COSP_OFF = BIG + 166 * MiB, SINP_OFF = BIG + 184 * MiB, COSS_OFF = BIG + 200 * MiB, SINS_OFF = BIG + 205 * MiB;
constexpr size_t PP_OFF = BIG + 210 * MiB, QP_OFF = BIG + 248 * MiB, PS_OFF = BIG + 282 * MiB, QS_OFF = BIG + 293 * MiB;
constexpr size_t WS_NEED = BIG + 660 * MiB;
constexpr size_t SSQ_STRIDE = 0;

struct Params { const float* in[25]; float* out; unsigned char* ws; int ph_lo, ph_hi; };

namespace pg8 {
constexpr int BM = 256, BK = 64, HALF = 128, HTB = HALF * BK * 2, STAGE_BYTES = 8 * HTB, NXCD = 8, WGM = 8;
DI int lds_byte(int r, int c) { const int st = (r >> 4) * 2 + (c >> 5), rr = r & 15, cc = c & 31, ob = rr * 64 + cc * 2; return st * 1024 + (ob ^ (((ob >> 9) & 1) << 5)); }
DI void stage_rc(int b, int& R, int& C) { const int st = b / 1024, sb = b % 1024, swz = sb ^ (((sb >> 9) & 1) << 5); R = (st >> 1) * 16 + swz / 64; C = (st & 1) * 32 + (swz % 64) / 2; }
DI int perm32(int rho) { const int n = rho >> 4, i = rho & 15; return 8 * (i >> 2) + 4 * n + (i & 3); }
struct Unit { int pm, pn, arow; };
struct Gemm { const bf16_t* A; const bf16_t* Bt; int M, N, K; };
struct StaticOrder {
    int nM, nN, nwg, G, c, rowmode;
    DI void init(int M, int N, int G_, int c_, int rm_ = 0) { nM = M / BM; nN = N / BM; nwg = nM * nN; G = G_; c = c_; rowmode = rm_; }
    DI bool next(int i, Unit& u) const {
        const long L = (long)i * G + c; if (L >= nwg) return false;
        int wgid = (int)L; { const int q = nwg / NXCD, r = nwg % NXCD, xcd = wgid % NXCD, off = wgid / NXCD; wgid = (xcd < r ? xcd * (q + 1) : r * (q + 1) + (xcd - r) * q) + off; }
        const int nig = WGM * nN, gid = wgid / nig, fm = gid * WGM, gsz = (nM - fm) < WGM ? (nM - fm) : WGM;
        u.pm = fm + ((wgid % nig) % gsz); u.pn = (wgid % nig) / gsz;
        if (rowmode == 0) u.arow = u.pm * 256;
        else { const int a = 254 * u.pm; u.arow = a < (T - 256) ? a : (T - 256); }
        return true;
    }
};
template <class Epi, class Sched>
DI void gemm_phase(LAS unsigned char* lds, const Gemm g, const Sched& S, const Epi& E, const int tid) {
    const int wid = __builtin_amdgcn_readfirstlane(tid >> 6), lane = tid & 63, wr = wid >> 2, wc = wid & 3, fr = lane & 15, fq = lane >> 4;
    const int K = g.K, nt = K / BK;
    unsigned voffA[2], voffB[2];
#pragma unroll
    for (int i = 0; i < 2; ++i) { int R, C; stage_rc(tid * 16 + i * 8192, R, C); const int Rb = Epi::PERM ? ((R & ~31) + perm32(R & 31)) : R;
        voffA[i] = (unsigned)(R * K + C) * 2u; voffB[i] = (unsigned)(Rb * K + C) * 2u; }
    const size_t kstep = (size_t)(BK * 2);
    const size_t hstep = (size_t)HALF * K * 2;
    const size_t tstep = 2 * hstep;
    const unsigned ldsw = (unsigned)wid * 1024u;
    const int aoff = lds_byte(wr * 64 + fr, fq * 8), boff = lds_byte(wc * 32 + fr, fq * 8);
#define PG8_SA(b, h) (((b) * 2 + (h)) * HTB)
#define PG8_SB(b, h) ((4 + (b) * 2 + (h)) * HTB)
#define PG8_STAGE(bufoff, gbase, voff) do { _Pragma("unroll") for (int _i = 0; _i < 2; ++_i) \
        __builtin_amdgcn_global_load_lds((const unsigned*)((const char*)(gbase) + (voff)[_i]), (LAS unsigned*)(lds + (bufoff) + ldsw + _i * 8192), 16, 0, 0); } while (0)
#define PG8_LDA(dst, b, h) do { _Pragma("unroll") for (int m = 0; m < 4; ++m) _Pragma("unroll") for (int k = 0; k < 2; ++k) dst[m][k] = *(const LAS bf16x8*)(lds + PG8_SA(b, h) + aoff + m * 2048 + k * 1024); } while (0)
#define PG8_LDB(dst, b, h) do { _Pragma("unroll") for (int n = 0; n < 2; ++n) _Pragma("unroll") for (int k = 0; k < 2; ++k) dst[n][k] = *(const LAS bf16x8*)(lds + PG8_SB(b, h) + boff + n * 2048 + k * 1024); } while (0)
#define PG8_MMA(ai, bj, At, Bt) do { __builtin_amdgcn_s_setprio(1); _Pragma("unroll") for (int m = 0; m < 4; ++m) _Pragma("unroll") for (int n = 0; n < 2; ++n) _Pragma("unroll") for (int k = 0; k < 2; ++k) \
        acc[ai][bj][m][n] = __builtin_amdgcn_mfma_f32_16x16x32_bf16(Bt[n][k], At[m][k], acc[ai][bj][m][n], 0, 0, 0); __builtin_amdgcn_s_setprio(0); } while (0)
#define PG8_WAIT_V(n) asm volatile("s_waitcnt vmcnt(" #n ")" ::: "memory")
#define PG8_WAIT_L(n) asm volatile("s_waitcnt lgkmcnt(" #n ")" ::: "memory")
#define PG8_BAR __builtin_amdgcn_s_barrier()
#define PG8_SCHED __builtin_amdgcn_sched_barrier(0)
    Unit cur, nxt; int ui = 0;
    if (!S.next(0, cur)) return;
    f32x4 acc[2][2][4][2];
#pragma unroll
    for (int a = 0; a < 2; ++a)
#pragma unroll
        for (int b = 0; b < 2; ++b)
#pragma unroll
            for (int m = 0; m < 4; ++m)
#pragma unroll
                for (int n = 0; n < 2; ++n) acc[a][b][m][n] = (f32x4){0.f, 0.f, 0.f, 0.f};
    bf16x8 At[4][2], B0[2][2], B1[2][2];
    const char* cA = (const char*)g.A + (size_t)cur.arow * K * 2; const char* cB = (const char*)g.Bt + (size_t)cur.pn * tstep;
    PG8_STAGE(PG8_SB(0, 0), cB, voffB); PG8_STAGE(PG8_SB(0, 1), cB + hstep, voffB); PG8_STAGE(PG8_SA(0, 0), cA, voffA); PG8_STAGE(PG8_SA(0, 1), cA + hstep, voffA);
    if (wr == 1) PG8_BAR;
    PG8_WAIT_V(2); PG8_BAR;
    PG8_STAGE(PG8_SB(1, 0), cB + kstep, voffB); PG8_STAGE(PG8_SA(1, 0), cA + kstep, voffA); PG8_STAGE(PG8_SB(1, 1), cB + hstep + kstep, voffB);
    PG8_WAIT_V(6); PG8_BAR;
    for (;;) {
        const bool has_next = S.next(ui + 1, nxt);
        const char* nA = has_next ? (const char*)g.A + (size_t)nxt.arow * K * 2 : cA; const char* nB = has_next ? (const char*)g.Bt + (size_t)nxt.pn * tstep : cB;
        for (int t = 0; t < nt; t += 2) {
            const bool last = (t == nt - 2);
            const char* a1 = cA + (size_t)(t + 1) * kstep;
            const char* a2 = last ? nA : cA + (size_t)(t + 2) * kstep; const char* b2 = last ? nB : cB + (size_t)(t + 2) * kstep;
            const char* a3 = a2 + kstep; const char* b3 = b2 + kstep;
            PG8_LDB(B0, 0, 0); PG8_LDB(B1, 0, 1); PG8_SCHED; PG8_LDA(At, 0, 0); PG8_STAGE(PG8_SA(1, 1), a1 + hstep, voffA);
            PG8_WAIT_V(8); PG8_WAIT_L(0); PG8_BAR; PG8_MMA(0, 0, At, B0); PG8_MMA(0, 1, At, B1); PG8_BAR; PG8_SCHED;
            PG8_LDA(At, 0, 1); PG8_STAGE(PG8_SB(0, 0), b2, voffB); PG8_STAGE(PG8_SB(0, 1), b2 + hstep, voffB); PG8_STAGE(PG8_SA(0, 0), a2, voffA);
            PG8_WAIT_V(8); PG8_WAIT_L(0); PG8_BAR; PG8_MMA(1, 0, At, B0); PG8_MMA(1, 1, At, B1); PG8_BAR; PG8_SCHED;
            PG8_LDB(B0, 1, 0); PG8_LDB(B1, 1, 1); PG8_SCHED; PG8_LDA(At, 1, 0); PG8_STAGE(PG8_SA(0, 1), a2 + hstep, voffA);
            PG8_WAIT_V(8); PG8_WAIT_L(0); PG8_BAR; PG8_MMA(0, 0, At, B0); PG8_MMA(0, 1, At, B1); PG8_BAR; PG8_SCHED;
            PG8_LDA(At, 1, 1); PG8_STAGE(PG8_SB(1, 0), b3, voffB); PG8_STAGE(PG8_SB(1, 1), b3 + hstep, voffB); PG8_STAGE(PG8_SA(1, 0), a3, voffA);
            PG8_WAIT_V(8); PG8_WAIT_L(0); PG8_BAR; PG8_MMA(1, 0, At, B0); PG8_MMA(1, 1, At, B1); PG8_BAR; PG8_SCHED;
        }
        if constexpr (Epi::ALIGN) { if (wr == 0) PG8_BAR; }
        E(acc, cur, wr, wc, fr, fq);
        if (!has_next) break;
#pragma unroll
        for (int a = 0; a < 2; ++a)
#pragma unroll
            for (int b = 0; b < 2; ++b)
#pragma unroll
                for (int m = 0; m < 4; ++m)
#pragma unroll
                    for (int n = 0; n < 2; ++n) acc[a][b][m][n] = (f32x4){0.f, 0.f, 0.f, 0.f};
        cur = nxt; cA = nA; cB = nB; ++ui;
        if constexpr (Epi::ALIGN) { if (wr == 1) PG8_BAR; }
    }
    PG8_WAIT_V(0);
    if constexpr (!Epi::ALIGN) { if (wr == 0) PG8_BAR; }
    PG8_BAR;
#undef PG8_SA
#undef PG8_SB
#undef PG8_STAGE
#undef PG8_LDA
#undef PG8_LDB
#undef PG8_MMA
#undef PG8_WAIT_V
#undef PG8_WAIT_L
#undef PG8_BAR
#undef PG8_SCHED
}
}
using pg8::Unit;
typedef f32x4 AccT[2][2][4][2];

DI float rowscale16(const float* ssp, int r, float eps) {
    const GAS f32x4* p = (const GAS f32x4*)(ssp + (size_t)r * 16);
    const f32x4 a = p[0], b = p[1], c = p[2], d = p[3];
    const float s = ((a[0] + a[1]) + (a[2] + a[3])) + ((b[0] + b[1]) + (b[2] + b[3])) + ((c[0] + c[1]) + (c[2] + c[3])) + ((d[0] + d[1]) + (d[2] + d[3]));
    return __builtin_amdgcn_rsqf(s * (1.0f / 1024.0f) + eps);
}
DI u32x4 pack8(const f32x4 a, const f32x4 b) { u32x4 w; w.x = pkbf(a[0], a[1]); w.y = pkbf(a[2], a[3]); w.z = pkbf(b[0], b[1]); w.w = pkbf(b[2], b[3]); return w; }
#define EPI_ROWS(rs, ssq, rb) float rs[2][4]; { f32x4 q_[2][4]; _Pragma("unroll") for (int ai_ = 0; ai_ < 2; ++ai_) _Pragma("unroll") for (int m_ = 0; m_ < 4; ++m_) \
        q_[ai_][m_] = *(const GAS f32x4*)((ssq) + (size_t)(u.arow + ai_ * 128 + wr * 64 + m_ * 16 + fr + (rb)) * 16 + 4 * fq); \
    _Pragma("unroll") for (int ai_ = 0; ai_ < 2; ++ai_) _Pragma("unroll") for (int m_ = 0; m_ < 4; ++m_) { \
        float p_ = (q_[ai_][m_][0] + q_[ai_][m_][1]) + (q_[ai_][m_][2] + q_[ai_][m_][3]); p_ += XSWZ(p_, 0x401F); p_ = xsum32(p_); \
        rs[ai_][m_] = __builtin_amdgcn_rsqf(p_ * (1.0f / 1024.0f) + 1e-6f); } }
#define EPI_COLS(s0, s1, ssq, c0) f32x4 s0, s1; { float v_[8]; _Pragma("unroll") for (int t_ = 0; t_ < 8; ++t_) v_[t_] = ldf((ssq) + (size_t)((c0) + t_) * 16 + fr); \
    _Pragma("unroll") for (int t_ = 0; t_ < 8; ++t_) { float p_ = v_[t_]; p_ += XSWZ(p_, 0x041F); p_ += XSWZ(p_, 0x081F); p_ += XSWZ(p_, 0x101F); p_ += XSWZ(p_, 0x201F); \
        const float r_ = __builtin_amdgcn_rsqf(p_ * (1.0f / 1024.0f) + 1e-6f); if (t_ < 4) s0[t_ & 3] = r_; else s1[t_ & 3] = r_; } }
struct EpiQK {
    static constexpr bool PERM = true; static constexpr bool ALIGN = true;
    bf16_t* O; const float* ssp; const float* cs; const float* sn; float qscale;
    DI void operator()(const AccT& acc, const Unit& u, int wr, int wc, int fr, int fq) const {
        const float hs = (u.pn < 4) ? qscale : 1.0f;
        EPI_ROWS(rs, ssp, 0);
#pragma unroll
        for (int ai = 0; ai < 2; ++ai) {
#pragma unroll
            for (int m = 0; m < 4; ++m) {
                const int r = u.arow + ai * 128 + wr * 64 + m * 16 + fr;
                const float sc = rs[ai][m] * hs;
                const int s = (r < TP) ? (r & (SP - 1)) : (r & (SS - 1));
                const GAS f32x4* cp = (const GAS f32x4*)(cs + s * 32 + 8 * fq); const GAS f32x4* sp = (const GAS f32x4*)(sn + s * 32 + 8 * fq);
                f32x4 o1[2], o2[2];
#pragma unroll
                for (int n = 0; n < 2; ++n) { const f32x4 c = cp[n], sv = sp[n]; const f32x4 x1 = acc[ai][0][m][n] * sc, x2 = acc[ai][1][m][n] * sc;
                    o1[n] = x1 * c - x2 * sv; o2[n] = x2 * c + x1 * sv; }
                bf16_t* op = O + (size_t)r * 2048 + u.pn * 256 + wc * 64 + 8 * fq;
                *(GAS u32x4*)op = pack8(o1[0], o1[1]); *(GAS u32x4*)(op + 32) = pack8(o2[0], o2[1]);
            }
            __builtin_amdgcn_sched_barrier(0);
        }
    }
};
struct EpiCol {
    static constexpr bool PERM = true; static constexpr bool ALIGN = true;
    bf16_t* O; size_t ld; const float* ssp;
    DI void operator()(const AccT& acc, const Unit& u, int wr, int wc, int fr, int fq) const {
#pragma unroll
        for (int bj = 0; bj < 2; ++bj) {
            const int c0 = u.pn * 256 + bj * 128 + wc * 32 + 8 * fq;
            EPI_COLS(s0, s1, ssp, c0);
#pragma unroll
            for (int ai = 0; ai < 2; ++ai)
#pragma unroll
                for (int m = 0; m < 4; ++m) { const int r = u.arow + ai * 128 + wr * 64 + m * 16 + fr;
                    *(GAS u32x4*)(O + (size_t)r * ld + c0) = pack8(acc[ai][bj][m][0] * s0, acc[ai][bj][m][1] * s1); }
        }
    }
};
struct EpiFZ {
    static constexpr bool PERM = true; static constexpr bool ALIGN = true;
    bf16_t* AP; bf16_t* AS; const float* ssp;
    DI void operator()(const AccT& acc, const Unit& u, int wr, int wc, int fr, int fq) const {
#pragma unroll
        for (int bj = 0; bj < 2; ++bj) {
            const int c0 = u.pn * 256 + bj * 128 + wc * 32 + 8 * fq;
            EPI_COLS(s0, s1, ssp, c0);
            bf16_t* base; int b, s, S;
            size_t nrt; if (c0 < TP) { base = AP; b = c0 >> 12; s = c0 & (SP - 1); S = SP; nrt = 8448; } else { const int c1 = c0 - TP; base = AS; b = c1 >> 11; s = c1 & (SS - 1); S = SS; nrt = 4352; }
#pragma unroll
            for (int ai = 0; ai < 2; ++ai)
#pragma unroll
                for (int m = 0; m < 4; ++m) { const int r = u.arow + ai * 128 + wr * 64 + m * 16 + fr;
                    const int g = r >> 8, jj = r & 255, part = jj > 128 ? 1 : 0, mm = jj - 128 * part;
                    const size_t row = (size_t)part * nrt + (size_t)(b * 516 + g * 129 + mm);
                    *(GAS u32x4*)(base + row * S + s) = pack8(acc[ai][bj][m][0] * s0, acc[ai][bj][m][1] * s1); }
        }
    }
};
struct EpiRow {
    static constexpr bool PERM = true; static constexpr bool ALIGN = true;
    bf16_t* O; int ldo; const float* ssp; float scale; int rbase;
    DI void operator()(const AccT& acc, const Unit& u, int wr, int wc, int fr, int fq) const {
        EPI_ROWS(rs, ssp, rbase);
#pragma unroll
        for (int ai = 0; ai < 2; ++ai)
#pragma unroll
            for (int m = 0; m < 4; ++m) { const int r = u.arow + ai * 128 + wr * 64 + m * 16 + fr;
                const float sc = rs[ai][m] * scale;
                bf16_t* op = O + (size_t)r * ldo + u.pn * 256 + wc * 32 + 8 * fq;
#pragma unroll
                for (int bj = 0; bj < 2; ++bj) __builtin_nontemporal_store(pack8(acc[ai][bj][m][0] * sc, acc[ai][bj][m][1] * sc), (GAS u32x4*)(op + bj * 128)); }
    }
};
struct EpiRes {
    static constexpr bool PERM = true; static constexpr bool ALIGN = true;
    bf16_t* XB; float* ssp;
    DI void operator()(const AccT& acc, const Unit& u, int wr, int wc, int fr, int fq) const {
#pragma unroll
        for (int ai = 0; ai < 2; ++ai) {
            u32x4 rv[4][2];
#pragma unroll
            for (int m = 0; m < 4; ++m)
#pragma unroll
                for (int bj = 0; bj < 2; ++bj) rv[m][bj] = *(const GAS u32x4*)(XB + (size_t)(u.arow + ai * 128 + wr * 64 + m * 16 + fr) * D + u.pn * 256 + bj * 128 + wc * 32 + 8 * fq);
#pragma unroll
            for (int m = 0; m < 4; ++m) { const int r = u.arow + ai * 128 + wr * 64 + m * 16 + fr;
                float ss = 0.f;
#pragma unroll
                for (int bj = 0; bj < 2; ++bj) { const int col = u.pn * 256 + bj * 128 + wc * 32 + 8 * fq;
                    const u32x4 q = rv[m][bj];
                    const f32x4 a = {bflo(q.x), bfhi(q.x), bflo(q.y), bfhi(q.y)}, b = {bflo(q.z), bfhi(q.z), bflo(q.w), bfhi(q.w)};
                    const f32x4 v0 = acc[ai][bj][m][0] + a, v1 = acc[ai][bj][m][1] + b;
                    *(GAS u32x4*)(XB + (size_t)r * D + col) = pack8(v0, v1);
                    ss += (v0[0] * v0[0] + v0[1] * v0[1]) + (v0[2] * v0[2] + v0[3] * v0[3]) + (v1[0] * v1[0] + v1[1] * v1[1]) + (v1[2] * v1[2] + v1[3] * v1[3]); }
                ss += XSWZ(ss, 0x401F); ss = xsum32(ss);
                if (fq == 0) stf(ssp + (size_t)r * 16 + u.pn * 4 + wc, ss); }
            __builtin_amdgcn_sched_barrier(0);
        }
    }
};
DI float gelu_tanh(float x) {
    const float z = 1.5957691216f * (x + 0.044715f * x * x * x);
    return x * __builtin_amdgcn_rcpf(1.0f + __builtin_amdgcn_exp2f(-1.4426950409f * z));
}
DI float dpp_f(float oldv, float src, const int ctrl_sel) {
    const int o = __float_as_int(oldv), s = __float_as_int(src); int r;
    if (ctrl_sel == 0) r = __builtin_amdgcn_update_dpp(o, s, 0x111, 0xf, 0xf, false);
    else if (ctrl_sel == 1) r = __builtin_amdgcn_update_dpp(o, s, 0x101, 0xf, 0xf, false);
    else if (ctrl_sel == 2) r = __builtin_amdgcn_update_dpp(o, s, 0x121, 0xf, 0xf, false);
    else r = __builtin_amdgcn_update_dpp(o, s, 0x12F, 0xf, 0xf, false);
    return __int_as_float(r);
}
struct EpiUp {
    static constexpr bool PERM = true; static constexpr bool ALIGN = true;
    bf16_t* U; const float* ssp; const float* cw; const float* cb; LAS float* ex;
    DI void operator()(AccT& acc, const Unit& u, int wr, int wc, int fr, int fq) const {
        EPI_ROWS(rs, ssp, 0);
#pragma unroll
        for (int ai = 0; ai < 2; ++ai)
#pragma unroll
            for (int m = 0; m < 4; ++m)
#pragma unroll
                for (int n = 0; n < 2; ++n) acc[ai][0][m][n] = acc[ai][0][m][n] * rs[ai][m];
        const int colw = wc * 32 + 8 * fq;
#pragma unroll
        for (int ai = 0; ai < 2; ++ai) { const int blk = 2 * ai + wr;
            if (fr == 0) {
#pragma unroll
                for (int n = 0; n < 2; ++n) *(LAS f32x4*)(ex + (blk * 2 + 0) * 128 + colw + 4 * n) = acc[ai][0][0][n]; }
            if (fr == 15) {
#pragma unroll
                for (int n = 0; n < 2; ++n) *(LAS f32x4*)(ex + (blk * 2 + 1) * 128 + colw + 4 * n) = acc[ai][0][3][n]; }
        }
        asm volatile("s_waitcnt lgkmcnt(0)" ::: "memory"); __builtin_amdgcn_s_barrier(); asm volatile("" ::: "memory");
#pragma unroll
        for (int n = 0; n < 2; ++n) {
            const int f0 = u.pn * 128 + colw + 4 * n;
            const f32x4 w0 = *(const GAS f32x4*)(cw + f0), w1 = *(const GAS f32x4*)(cw + FF + f0), w2 = *(const GAS f32x4*)(cw + 2 * FF + f0), bb = *(const GAS f32x4*)(cb + f0);
#pragma unroll
            for (int ai = 0; ai < 2; ++ai) { const int blk = 2 * ai + wr;
                f32x4 pe = {0.f, 0.f, 0.f, 0.f}, ne = {0.f, 0.f, 0.f, 0.f};
                if (blk > 0) pe = *(const LAS f32x4*)(ex + ((blk - 1) * 2 + 1) * 128 + colw + 4 * n);
                if (blk < 3) ne = *(const LAS f32x4*)(ex + ((blk + 1) * 2 + 0) * 128 + colw + 4 * n);
#pragma unroll
                for (int m = 0; m < 4; ++m) {
                    const int local = ai * 128 + wr * 64 + m * 16 + fr, ra = u.arow + local;
                    const int S = (ra < TP) ? SP : SS, s = ra & (S - 1);
                    const float fm = (s > 0) ? 1.0f : 0.0f, fn = (s < S - 1) ? 1.0f : 0.0f;
                    const bool valid = (local > 0 || ra == 0) && (local < 255 || ra == T - 1);
                    f32x4 cv;
#pragma unroll
                    for (int j = 0; j < 4; ++j) {
                        const float g = acc[ai][0][m][n][j];
                        const float oldu = (m > 0) ? dpp_f(0.f, acc[ai][0][m > 0 ? m - 1 : 0][n][j], 2) : pe[j];
                        const float oldd = (m < 3) ? dpp_f(0.f, acc[ai][0][m < 3 ? m + 1 : 3][n][j], 3) : ne[j];
                        const float up = dpp_f(oldu, g, 0), dn = dpp_f(oldd, g, 1);
                        cv[j] = (fm * up) * w0[j] + (g * w1[j] + ((fn * dn) * w2[j] + bb[j])); }
                    const f32x4 tt = cv * (cv * cv * (-0.1029432397f) + (-2.3022081820f));
                    const f32x4 xv = cv * (acc[ai][1][m][n] * rs[ai][m]);
                    f32x4 o;
#pragma unroll
                    for (int j = 0; j < 4; ++j) o[j] = xv[j] * __builtin_amdgcn_rcpf(1.0f + __builtin_amdgcn_exp2f(tt[j]));
                    u32x2 w; w.x = pkbf(o[0], o[1]); w.y = pkbf(o[2], o[3]);
                    if (valid) *(GAS u32x2*)(U + (size_t)ra * FF + f0) = w; }
            }
        }
        asm volatile("s_waitcnt lgkmcnt(0)" ::: "memory");
    }
};
struct EpiDFT {
    static constexpr bool PERM = true; static constexpr bool ALIGN = true;
    bf16_t* O; int ldo;
    DI void operator()(const AccT& acc, const Unit& u, int wr, int wc, int fr, int fq) const {
#pragma unroll
        for (int ai = 0; ai < 2; ++ai)
#pragma unroll
            for (int m = 0; m < 4; ++m) { const int r = u.arow + ai * 128 + wr * 64 + m * 16 + fr;
                bf16_t* op = O + (size_t)r * ldo + u.pn * 256 + wc * 32 + 8 * fq;
#pragma unroll
                for (int bj = 0; bj < 2; ++bj) *(GAS u32x4*)(op + bj * 128) = pack8(acc[ai][bj][m][0], acc[ai][bj][m][1]); }
    }
};
DI void dft_combine(LAS unsigned char* lds, const bf16_t* P, int ldp, const bf16_t* Q, int ldq, bf16_t* FB, int S, int nb, float scale, int bid, int G, int tid) {
    LAS float* y1 = (LAS float*)lds; LAS float* y2 = y1 + 129 * 65;
    const int nkb = S >> 7, nitems = nb * 4 * nkb;
    for (int it = bid; it < nitems; it += G) {
        const int kb = it % nkb, bg = it / nkb, b = bg >> 2, g = bg & 3, k0 = kb * 64;
        __syncthreads();
        for (int idx = tid; idx < 129 * 64; idx += 512) { const int m = idx >> 6, kk = idx & 63; const size_t R = (size_t)(b * 516 + g * 129 + m);
            const float pv = __uint_as_float((unsigned)(*(const GAS bf16_t*)(P + R * ldp + k0 + kk)) << 16), qv = __uint_as_float((unsigned)(*(const GAS bf16_t*)(Q + R * ldq + k0 + kk)) << 16);
            y1[m * 65 + kk] = (pv - qv) * scale; y2[m * 65 + kk] = (pv + qv) * scale; }
        __syncthreads();
        const int tsel = tid >> 8, c = tid & 255, mi = (c <= 128) ? c : 256 - c;
        const LAS float* src = ((c <= 128) == (tsel == 0)) ? y1 : y2;
        for (int kk = 0; kk < 64; ++kk) { const int k = k0 + kk, tok = tsel ? ((S - k) & (S - 1)) : k;
            const float v = src[mi * 65 + kk];
            if (!(tsel && k == 0)) sth(FB + ((size_t)(b * S + tok)) * D + g * 256 + c, (bf16_t)(pkbf(v, 0.f) & 0xffffu)); }
    }
    for (int it = bid; it < nb * 4; it += G) {
        const int b = it >> 2, g = it & 3;
        if (tid < 256) { const int c = tid, mi = (c <= 128) ? c : 256 - c; const size_t R = (size_t)(b * 516 + g * 129 + mi);
            const float v = __uint_as_float((unsigned)(*(const GAS bf16_t*)(P + R * ldp + (S >> 1))) << 16) * scale;
            sth(FB + ((size_t)(b * S + (S >> 1))) * D + g * 256 + c, (bf16_t)(pkbf(v, 0.f) & 0xffffu)); }
    }
    __syncthreads();
}

DI int swap23(int x) { return (x & ~12) | ((x & 4) << 1) | ((x & 8) >> 1); }
template <int DK, int KCOLS, bool DIFF>
DI void attn_unit(LAS unsigned char* lds, const bf16_t* Q, int q_ld, const bf16_t* K, int k_ld, const bf16_t* Vt, size_t vt_ld, int nkeys,
                  bf16_t* Oout, float lam, const float* subg, const int tid) {
    constexpr int KROWB = KCOLS * 2 + 16, KCH = KCOLS / 8, KBYTES = 64 * KROWB, VROWB = 144, VBYTES = 128 * VROWB, BUFB = KBYTES + VBYTES;
    constexpr int NKL = KCH * 64 / 512, NS = DK / 16, EXOFF = 2 * BUFB;
    static_assert(EXOFF + (DIFF ? 65536 : 0) <= LDS_BYTES, "attention LDS");
    const int wid = __builtin_amdgcn_readfirstlane(tid >> 6), lane = tid & 63, n = lane & 31, hh = lane >> 5;
    const int qs = DIFF ? (wid >> 1) : wid, c = DIFF ? (wid & 1) : 0;
    bf16x8 qf[NS];
    { const bf16_t* qrow = Q + (size_t)(qs * 32 + n) * q_ld + c * DK + 8 * hh;
#pragma unroll
      for (int s = 0; s < NS; ++s) qf[s] = *(const GAS bf16x8*)(qrow + 16 * s); }
    f32x16 o[4];
    float mrun = -1e30f, lrun = 0.f;
#pragma unroll
    for (int e = 0; e < 4; ++e)
#pragma unroll
        for (int i = 0; i < 16; ++i) o[e][i] = 0.f;
    u32x4 kreg[2][NKL], vreg[2][2];
    const int stid = DIFF ? ((wid >> 2) * 512 + (tid & 255)) : tid;
    constexpr int SSTR = DIFF ? 256 : 512;
#define AT_GLOAD(t, P) do { _Pragma("unroll") for (int i_ = 0; i_ < NKL; ++i_) { const int ci = stid + SSTR * i_, row = ci / KCH, col = ci % KCH; \
            kreg[P][i_] = *(const GAS u32x4*)(K + (size_t)((t) * 64 + row) * k_ld + col * 8); } \
        _Pragma("unroll") for (int i_ = 0; i_ < 2; ++i_) { const int ci = stid + SSTR * i_, row = ci >> 3, col = ci & 7; \
            vreg[P][i_] = *(const GAS u32x4*)(Vt + (size_t)row * vt_ld + (t) * 64 + col * 8); } } while (0)
#define AT_LSTORE_K(buf, P) do { _Pragma("unroll") for (int i_ = 0; i_ < NKL; ++i_) { const int ci = stid + SSTR * i_, row = ci / KCH, col = ci % KCH; \
            *(LAS u32x4*)(lds + (buf) * BUFB + row * KROWB + col * 16) = kreg[P][i_]; } } while (0)
#define AT_LSTORE_V(buf, P) do { _Pragma("unroll") for (int i_ = 0; i_ < 2; ++i_) { const int ci = stid + SSTR * i_, row = ci >> 3, col = ci & 7; \
            *(LAS u32x4*)(lds + (buf) * BUFB + KBYTES + row * VROWB + col * 16) = vreg[P][i_]; } } while (0)
    AT_GLOAD(0, 0); AT_LSTORE_K(0, 0); AT_LSTORE_V(0, 0); __syncthreads();
#define AT_LBAR do { asm volatile("s_waitcnt lgkmcnt(0)" ::: "memory"); __builtin_amdgcn_s_barrier(); asm volatile("" ::: "memory"); } while (0)
    const int nt = nkeys >> 6;
    const int krow0 = swap23(n);
    if constexpr (DIFF) {
        if (nt > 1) AT_GLOAD(1, 1);
        if (wid >= 4) AT_LBAR;
#pragma unroll 1
        for (int t0 = 0; t0 < nt; t0 += 2) {
#pragma unroll
        for (int par = 0; par < 2; ++par) {
            const int t = t0 + par;
            const int buf = par;
            if (t + 2 < nt) AT_GLOAD(t + 2, par);
            const LAS unsigned char* kb_ = lds + buf * BUFB; const LAS unsigned char* vb_ = kb_ + KBYTES;
            f32x16 sa[2];
            {
                const LAS unsigned char* kp0 = kb_ + krow0 * KROWB + c * DK * 2 + 16 * hh; const LAS unsigned char* kp1 = kp0 + 32 * KROWB;
                bf16x8 ka[NS], kc[NS];
#pragma unroll
                for (int s = 0; s < NS; ++s) ka[s] = *(const LAS bf16x8*)(kp0 + 32 * s);
#pragma unroll
                for (int i = 0; i < 16; ++i) { sa[0][i] = 0.f; sa[1][i] = 0.f; }
                __builtin_amdgcn_sched_barrier(0);
#pragma unroll
                for (int s = 0; s < NS; ++s) kc[s] = *(const LAS bf16x8*)(kp1 + 32 * s);
#pragma unroll
                for (int s = 0; s < NS; ++s) sa[0] = __builtin_amdgcn_mfma_f32_32x32x16_bf16(ka[s], qf[s], sa[0], 0, 0, 0);
                __builtin_amdgcn_sched_barrier(0);
#pragma unroll
                for (int s = 0; s < NS; ++s) sa[1] = __builtin_amdgcn_mfma_f32_32x32x16_bf16(kc[s], qf[s], sa[1], 0, 0, 0);
            }
            float mx = sa[0][0];
#pragma unroll
            for (int kb = 0; kb < 2; ++kb)
#pragma unroll
                for (int i = 0; i < 16; ++i) mx = fmaxf(mx, sa[kb][i]);
            mx = xmax32(mx);
            const float mnew = fmaxf(mrun, mx);
            const float alpha = __builtin_amdgcn_exp2f(mrun - mnew);
            mrun = mnew;
            float rs = 0.f;
            bf16x8 pf[2][2];
#pragma unroll
            for (int i = 0; i < 16; ++i) { const float pv = __builtin_amdgcn_exp2f(sa[0][i] - mnew); sa[0][i] = pv; rs += pv; }
#pragma unroll
            for (int s2 = 0; s2 < 2; ++s2) {
                u32x4 pw; pw.x = pkbf(sa[0][8 * s2 + 0], sa[0][8 * s2 + 1]); pw.y = pkbf(sa[0][8 * s2 + 2], sa[0][8 * s2 + 3]);
                pw.z = pkbf(sa[0][8 * s2 + 4], sa[0][8 * s2 + 5]); pw.w = pkbf(sa[0][8 * s2 + 6], sa[0][8 * s2 + 7]);
                pf[0][s2] = __builtin_bit_cast(bf16x8, pw); }
            if (t + 1 < nt) AT_LSTORE_K(buf ^ 1, par ^ 1);
            AT_LBAR;
            if (t + 1 < nt) AT_LSTORE_V(buf ^ 1, par ^ 1);
#pragma unroll
            for (int i = 0; i < 16; ++i) { const float pv = __builtin_amdgcn_exp2f(sa[1][i] - mnew); sa[1][i] = pv; rs += pv; }
#pragma unroll
            for (int s2 = 0; s2 < 2; ++s2) {
                u32x4 pw; pw.x = pkbf(sa[1][8 * s2 + 0], sa[1][8 * s2 + 1]); pw.y = pkbf(sa[1][8 * s2 + 2], sa[1][8 * s2 + 3]);
                pw.z = pkbf(sa[1][8 * s2 + 4], sa[1][8 * s2 + 5]); pw.w = pkbf(sa[1][8 * s2 + 6], sa[1][8 * s2 + 7]);
                pf[1][s2] = __builtin_bit_cast(bf16x8, pw); }
            lrun = lrun * alpha + rs;
            if (__builtin_amdgcn_ballot_w64(alpha != 1.0f) != 0ull) {
#pragma unroll
                for (int e = 0; e < 4; ++e) o[e] = o[e] * alpha;
            }
            {
                const LAS unsigned char* vp = vb_ + n * VROWB + 16 * hh;
                bf16x8 va[4], vc[4];
#pragma unroll
                for (int e = 0; e < 4; ++e) va[e] = *(const LAS bf16x8*)(vp + e * 32 * VROWB);
                __builtin_amdgcn_sched_barrier(0);
#pragma unroll
                for (int e = 0; e < 4; ++e) vc[e] = *(const LAS bf16x8*)(vp + e * 32 * VROWB + 32);
#pragma unroll
                for (int e = 0; e < 4; ++e) o[e] = __builtin_amdgcn_mfma_f32_32x32x16_bf16(va[e], pf[0][0], o[e], 0, 0, 0);
                __builtin_amdgcn_sched_barrier(0);
#pragma unroll
                for (int e = 0; e < 4; ++e) va[e] = *(const LAS bf16x8*)(vp + e * 32 * VROWB + 64);
#pragma unroll
                for (int e = 0; e < 4; ++e) o[e] = __builtin_amdgcn_mfma_f32_32x32x16_bf16(vc[e], pf[0][1], o[e], 0, 0, 0);
                __builtin_amdgcn_sched_barrier(0);
#pragma unroll
                for (int e = 0; e < 4; ++e) vc[e] = *(const LAS bf16x8*)(vp + e * 32 * VROWB + 96);
#pragma unroll
                for (int e = 0; e < 4; ++e) o[e] = __builtin_amdgcn_mfma_f32_32x32x16_bf16(va[e], pf[1][0], o[e], 0, 0, 0);
                __builtin_amdgcn_sched_barrier(0);
#pragma unroll
                for (int e = 0; e < 4; ++e) o[e] = __builtin_amdgcn_mfma_f32_32x32x16_bf16(vc[e], pf[1][1], o[e], 0, 0, 0);
            }
            AT_LBAR;
        }
        }
        if (wid < 4) AT_LBAR;
    } else {
#pragma unroll 1
        for (int t = 0; t < nt; ++t) {
            const int buf = t & 1;
            if (t + 1 < nt) { AT_GLOAD(t + 1, 0); AT_LSTORE_K(buf ^ 1, 0); AT_LSTORE_V(buf ^ 1, 0); }
            const LAS unsigned char* kb_ = lds + buf * BUFB; const LAS unsigned char* vb_ = kb_ + KBYTES;
#pragma unroll
            for (int kb = 0; kb < 2; ++kb) {
                f32x16 sa;
#pragma unroll
                for (int i = 0; i < 16; ++i) sa[i] = 0.f;
                const LAS unsigned char* kp = kb_ + (kb * 32 + krow0) * KROWB + c * DK * 2 + 16 * hh;
#pragma unroll
                for (int s = 0; s < NS; ++s) { const bf16x8 kf = *(const LAS bf16x8*)(kp + 32 * s); sa = __builtin_amdgcn_mfma_f32_32x32x16_bf16(kf, qf[s], sa, 0, 0, 0);
                    if (NS > 4 && (s & 3) == 3) __builtin_amdgcn_sched_barrier(0); }
                float mx = sa[0];
#pragma unroll
                for (int i = 1; i < 16; ++i) mx = fmaxf(mx, sa[i]);
                mx = xmax32(mx);
                const float mnew = fmaxf(mrun, mx);
                const float alpha = __builtin_amdgcn_exp2f(mrun - mnew);
                mrun = mnew;
                float rs = 0.f;
#pragma unroll
                for (int i = 0; i < 16; ++i) { const float pv = __builtin_amdgcn_exp2f(sa[i] - mnew); sa[i] = pv; rs += pv; }
                lrun = lrun * alpha + rs;
                if (__builtin_amdgcn_ballot_w64(alpha != 1.0f) != 0ull) {
#pragma unroll
                    for (int e = 0; e < 4; ++e) o[e] = o[e] * alpha;
                }
#pragma unroll
                for (int s2 = 0; s2 < 2; ++s2) {
                    u32x4 pw; pw.x = pkbf(sa[8 * s2 + 0], sa[8 * s2 + 1]); pw.y = pkbf(sa[8 * s2 + 2], sa[8 * s2 + 3]);
                    pw.z = pkbf(sa[8 * s2 + 4], sa[8 * s2 + 5]); pw.w = pkbf(sa[8 * s2 + 6], sa[8 * s2 + 7]);
                    const bf16x8 pf = __builtin_bit_cast(bf16x8, pw);
                    const LAS unsigned char* vp = vb_ + n * VROWB + (kb * 32 + 16 * s2 + 8 * hh) * 2;
#pragma unroll
                    for (int e = 0; e < 4; ++e) { const bf16x8 vf = *(const LAS bf16x8*)(vp + e * 32 * VROWB); o[e] = __builtin_amdgcn_mfma_f32_32x32x16_bf16(vf, pf, o[e], 0, 0, 0); }
                }
                __builtin_amdgcn_sched_barrier(0);
            }
            __syncthreads();
        }
    }
#undef AT_LBAR
#undef AT_GLOAD
#undef AT_LSTORE_K
#undef AT_LSTORE_V
    bf16_t* orow = Oout + (size_t)(qs * 32 + n) * D;
    const float ltot = xsum32(lrun);
    if constexpr (DIFF) {
        LAS float* ex = (LAS float*)(lds + EXOFF) + qs * 4096 + lane;
        if (c == 1) { const float i2 = lam / ltot;
#pragma unroll
            for (int e = 0; e < 4; ++e)
#pragma unroll
                for (int i = 0; i < 16; ++i) ex[(e * 16 + i) * 64] = o[e][i] * i2; }
        __syncthreads();
        if (c == 0) {
            const float i1 = 1.0f / ltot;
            float ss = 0.f;
#pragma unroll
            for (int e = 0; e < 4; ++e)
#pragma unroll
                for (int i = 0; i < 16; ++i) { const float v = o[e][i] * i1 - ex[(e * 16 + i) * 64]; o[e][i] = v; ss += v * v; }
            ss = xsum32(ss);
            const float rn = __builtin_amdgcn_rsqf(ss * (1.0f / 128.0f) + 1e-5f) * 0.8f;
#pragma unroll
            for (int e = 0; e < 4; ++e)
#pragma unroll
                for (int g4 = 0; g4 < 4; ++g4) { const int e0 = e * 32 + 8 * g4 + 4 * hh; const f32x4 gv = *(const GAS f32x4*)(subg + e0);
                    u32x2 w; w.x = pkbf(o[e][4 * g4] * rn * gv[0], o[e][4 * g4 + 1] * rn * gv[1]); w.y = pkbf(o[e][4 * g4 + 2] * rn * gv[2], o[e][4 * g4 + 3] * rn * gv[3]);
                    *(GAS u32x2*)(orow + e0) = w; }
        }
    } else {
        const float i1 = 1.0f / ltot;
#pragma unroll
        for (int e = 0; e < 4; ++e)
#pragma unroll
            for (int g4 = 0; g4 < 4; ++g4) { const int e0 = e * 32 + 8 * g4 + 4 * hh;
                u32x2 w; w.x = pkbf(o[e][4 * g4] * i1, o[e][4 * g4 + 1] * i1); w.y = pkbf(o[e][4 * g4 + 2] * i1, o[e][4 * g4 + 3] * i1);
                *(GAS u32x2*)(orow + e0) = w; }
    }
    __syncthreads();
}


DI void wconv(bf16_t* dst, const float* src, int ld, int coff, int N, int K, const float* g, int perm, int gtid, int gsz) {
    const int items = N * (K / 8);
    for (int id = gtid; id < items; id += gsz) {
        const int n = id % N, kg = id / N;
        int col = n;
        if (perm == 1) { const int p = n & 255; col = (n & ~255) + 64 * ((p & 127) >> 5) + 32 * (p >> 7) + (p & 31); }
        else if (perm == 2) { const int p = n & 255, pn = n >> 8; col = (p < 128) ? (128 * pn + p) : (FF + 128 * pn + (p - 128)); }
        const float* s = src + (size_t)(kg * 8) * ld + coff + col;
        float v[8];
#pragma unroll
        for (int i = 0; i < 8; ++i) v[i] = ldf(s + (size_t)i * ld) * (g ? ldf(g + kg * 8 + i) : 1.0f);
        u32x4 w; w.x = pkbf(v[0], v[1]); w.y = pkbf(v[2], v[3]); w.z = pkbf(v[4], v[5]); w.w = pkbf(v[6], v[7]);
        *(GAS u32x4*)(dst + (size_t)n * K + kg * 8) = w;
    }
}
DI void act_conv(const float* x, bf16_t* xb, float* ssq, int rows, int bid, int nb, int tid) {
    const int lane = tid & 63;
    for (int r = bid * 8 + (tid >> 6); r < rows; r += nb * 8) {
        float ss = 0.f;
#pragma unroll
        for (int h = 0; h < 2; ++h) { const int c0 = h * 512 + lane * 8;
            const f32x4 a = __builtin_nontemporal_load((const GAS f32x4*)(x + (size_t)r * D + c0)), b = __builtin_nontemporal_load((const GAS f32x4*)(x + (size_t)r * D + c0 + 4));
            ss += (a[0] * a[0] + a[1] * a[1]) + (a[2] * a[2] + a[3] * a[3]) + (b[0] * b[0] + b[1] * b[1]) + (b[2] * b[2] + b[3] * b[3]);
            *(GAS u32x4*)(xb + (size_t)r * D + c0) = pack8(a, b); }
        ss += XSWZ(ss, 0x041F); ss += XSWZ(ss, 0x081F); ss += XSWZ(ss, 0x101F); ss += XSWZ(ss, 0x201F); ss += XSWZ(ss, 0x401F); ss = xsum32(ss);
        if (lane < 16) stf(ssq + (size_t)r * 16 + lane, (lane == 0) ? ss : 0.0f);
    }
}
DI void zero_fill(void* p, size_t bytes, int gtid, int gsz) {
    GAS u32x4* q = (GAS u32x4*)p; const size_t n = bytes / 16; unsigned zz = 0u; LAUNDER_V(zz); const u32x4 z = {zz, zz, zz, zz};
    for (size_t i = gtid; i < n; i += gsz) q[i] = z;
}

enum { T_QK = 0, T_COL, T_FZ, T_ROW, T_RES, T_GLU, T_DFT };
struct Job { int type; const bf16_t* A; const bf16_t* Bt; int M, N, K, rot; int l, h; };

#define XB_TMO      128
#define XB_XCNT(j)  (256  + 64 * (j))
#define XB_XSUB(j)  (1280 + 64 * (j))
#define XB_XGEN(j)  (2304 + 64 * (j))
#define XB_TOP      3328
#define XB_TOPGEN   3392
#define XCD_BAR_WORDS 3456
#define XB_SPIN_CAP (1u << 20)
DI unsigned xb_ld(unsigned* p)              { return __hip_atomic_load(p, __ATOMIC_RELAXED, __HIP_MEMORY_SCOPE_AGENT); }
DI unsigned xb_add(unsigned* p, unsigned v) { return __hip_atomic_fetch_add(p, v, __ATOMIC_RELAXED, __HIP_MEMORY_SCOPE_AGENT); }
DI unsigned xb_xcc_id() { return (unsigned)__builtin_amdgcn_s_getreg((3 << 11) | 20) & 0xFu; }
#define XB_SPIN(cond, bar) do { unsigned _sp = 0; while (cond) { __builtin_amdgcn_s_sleep(1); \
    if ((++_sp & 255u) == 0u) { if (xb_ld(&(bar)[XB_TMO])) break; if (_sp > XB_SPIN_CAP) { atomicAdd(&(bar)[XB_TMO], 1u); break; } } } } while (0)
struct XcdBarrier { unsigned* bar; unsigned x; volatile LAS unsigned* st; };
DI XcdBarrier xcd_barrier_post(unsigned* bar, volatile LAS unsigned* st) {
    XcdBarrier b; b.bar = bar; b.x = xb_xcc_id(); b.st = st;
    if (threadIdx.x == 0) (void)xb_add(&bar[XB_XCNT(b.x)], 1u);
    return b;
}
DI void xcd_barrier_complete(unsigned* bar, unsigned x, unsigned& nloc, unsigned& nx) {
    const unsigned G = gridDim.x * gridDim.y * gridDim.z;
    unsigned sum, cnt, mine, sp = 0u;
    for (;;) {
        sum = 0u; cnt = 0u; mine = 0u;
#pragma unroll
        for (unsigned j = 0; j < 16; ++j) { const unsigned c = xb_ld(&bar[XB_XCNT(j)]); sum += c; cnt += (c > 0u) ? 1u : 0u; mine = (j == x) ? c : mine; }
        if (sum == G) break;
        __builtin_amdgcn_s_sleep(1);
        if ((++sp & 255u) == 0u) { if (xb_ld(&bar[XB_TMO])) break; if (sp > XB_SPIN_CAP) { atomicAdd(&bar[XB_TMO], 1u); break; } }
    }
    nloc = mine > 0u ? mine : 1u; nx = cnt > 0u ? cnt : 1u;
}
DI void xcd_barrier(const XcdBarrier& b) {
    asm volatile("s_waitcnt vmcnt(0)" ::: "memory");
    __syncthreads();
    if (threadIdx.x == 0) {
        unsigned* bar = b.bar;
        __builtin_amdgcn_s_waitcnt(0);
        unsigned nloc = b.st[0], nx = b.st[1];
        if (nloc == 0u) { xcd_barrier_complete(bar, b.x, nloc, nx); b.st[0] = nloc; b.st[1] = nx; }
        const unsigned old = xb_add(&bar[XB_XSUB(b.x)], 1u);
        const unsigned gen = old / nloc;
        if (old + 1u == (gen + 1u) * nloc) {
            __builtin_amdgcn_fence(__ATOMIC_RELEASE, "agent");
            asm volatile("s_waitcnt vmcnt(0)" ::: "memory");
            const unsigned og = xb_add(&bar[XB_TOP], 1u);
            const unsigned tg = og / nx;
            if (og + 1u == (tg + 1u) * nx) xb_add(&bar[XB_TOPGEN], 1u);
            else XB_SPIN(xb_ld(&bar[XB_TOPGEN]) == tg, bar);
            __builtin_amdgcn_fence(__ATOMIC_ACQUIRE, "agent");
            xb_add(&bar[XB_XGEN(b.x)], 1u);
            asm volatile("s_waitcnt vmcnt(0)" ::: "memory");
        } else {
            XB_SPIN(xb_ld(&bar[XB_XGEN(b.x)]) == gen, bar);
            __builtin_amdgcn_fence(__ATOMIC_ACQUIRE, "agent");
            asm volatile("s_waitcnt vmcnt(0)" ::: "memory");
        }
    }
    __syncthreads();
}
constexpr size_t BAR_OFF = TAB_OFF + 32 * 1024;

__global__ void __launch_bounds__(512, 2) mk_fwd(Params p) {
    extern __shared__ __attribute__((aligned(16))) unsigned char smem[];
    LAS unsigned char* lds = (LAS unsigned char*)smem;
    XcdBarrier xbar; xbar.bar = (unsigned*)(p.ws + BAR_OFF); xbar.x = 0; xbar.st = (volatile LAS unsigned*)(lds + LDS_BYTES - 64);
    if (p.ph_hi - p.ph_lo > 1) {
        if (threadIdx.x == 0) { xbar.st[0] = 0u; xbar.st[1] = 0u; }
        __syncthreads();
        xbar = xcd_barrier_post((unsigned*)(p.ws + BAR_OFF), (volatile LAS unsigned*)(lds + LDS_BYTES - 64));
    }
    if (p.ph_lo == 0) {
        const int ph = 0;
        unsigned char* ws = p.ws; float* X = p.out; int tid = threadIdx.x, bid = blockIdx.x;
        LAUNDER_P(ws); LAUNDER_P(X); asm volatile("" : "+v"(tid)); asm volatile("" : "+s"(bid));
        const int G = gridDim.x, gtid = bid * 512 + tid, gsz = G * 512;
        bf16_t* const XB = (bf16_t*)(ws + XB_OFF); float* const SSPp = (float*)(ws + SSP_OFF); float* const MSSP = (float*)(ws + MSSP_OFF);
        bf16_t* const MEMB = (bf16_t*)(ws + MEMB_OFF); float* const TAB = (float*)(ws + TAB_OFF);
            LAS float* tab = (LAS float*)lds;
            for (int j = tid; j < 4096; j += 512) { const float v = cospif((float)j * (1.0f / 2048.0f)); tab[j] = v; if (bid == 0) stf(TAB + j, v); }
            __syncthreads();
            const float* g_mix = p.in[4]; const float* g_xa = p.in[5]; const float* g_mem = p.in[6]; const float* g_ffn = p.in[7];
            wconv((bf16_t*)(ws + W_QK), p.in[9], 3072, 0, 2048, D, g_mix, 1, gtid, gsz);
            wconv((bf16_t*)(ws + W_V), p.in[9], 3072, 2048, 1024, D, g_mix, 0, gtid, gsz);
            wconv((bf16_t*)(ws + W_O), p.in[15], 1024, 0, 1024, D, nullptr, 0, gtid, gsz);
            wconv((bf16_t*)(ws + W_FO), p.in[17], 1024, 0, 1024, D, nullptr, 0, gtid, gsz);
            for (int l = 0; l < 2; ++l) {
                wconv((bf16_t*)(ws + W_XQ + l * 2 * MiB), p.in[18] + (size_t)l * D * D, 1024, 0, 1024, D, g_xa + l * D, 0, gtid, gsz);
                wconv((bf16_t*)(ws + W_XK + l * 2 * MiB), p.in[19] + (size_t)l * D * 2048, 2048, 0, 1024, D, g_mem + l * D, 0, gtid, gsz);
                wconv((bf16_t*)(ws + W_XV + l * 2 * MiB), p.in[19] + (size_t)l * D * 2048, 2048, 1024, 1024, D, g_mem + l * D, 0, gtid, gsz);
                wconv((bf16_t*)(ws + W_XO + l * 2 * MiB), p.in[20] + (size_t)l * D * D, 1024, 0, 1024, D, nullptr, 0, gtid, gsz);
                wconv((bf16_t*)(ws + W_G + l * 2 * WFFN), p.in[21] + (size_t)l * D * 2 * FF, 2 * FF, 0, 2 * FF, D, g_ffn + l * D, 2, gtid, gsz);
                wconv((bf16_t*)(ws + W_D + l * WFFN), p.in[24] + (size_t)l * FF * D, 1024, 0, 1024, FF, nullptr, 0, gtid, gsz);
            }
            { const float* win = p.in[16]; bf16_t* wab = (bf16_t*)(ws + W_AB);
              for (int id = gtid; id < 1024 * 128; id += gsz) {
                  const int n = id & 1023, kg = id >> 10, gq = n >> 8, jj = n & 255, issin = jj > 128 ? 1 : 0, mm = jj - 128 * issin;
                  float a[8];
#pragma unroll
                  for (int i = 0; i < 8; ++i) a[i] = 0.f;
                  const float* wp = win + (size_t)(kg * 8) * D + gq * 256;
                  for (int c = 0; c < 256; ++c) {
                      float tv = tab[(16 * mm * c + 1024 * issin) & 4095]; if (issin) tv = -tv;
#pragma unroll
                      for (int i = 0; i < 8; ++i) a[i] += ldf(wp + (size_t)i * D + c) * tv;
                  }
                  const float* gm1 = g_mix + D + kg * 8;
                  u32x4 w; w.x = pkbf(a[0] * gm1[0], a[1] * gm1[1]); w.y = pkbf(a[2] * gm1[2], a[3] * gm1[3]); w.z = pkbf(a[4] * gm1[4], a[5] * gm1[5]); w.w = pkbf(a[6] * gm1[6], a[7] * gm1[7]);
                  *(GAS u32x4*)(wab + (size_t)n * D + kg * 8) = w;
              } }
            act_conv(p.in[0], XB, SSPp, TP, bid, G, tid);
            act_conv(p.in[1], XB + (size_t)TP * D, SSPp + (size_t)TP * 16, TS, bid, G, tid);
            act_conv(p.in[2], MEMB, MSSP, 4096, bid, G, tid);
            act_conv(p.in[3], MEMB + (size_t)4096 * D, MSSP + 4096 * 16, 2048, bid, G, tid);
            { float* cs = (float*)(ws + ROPE_C); float* sn = (float*)(ws + ROPE_S);
              for (int id = gtid; id < 4096 * 32; id += gsz) { const int s = id >> 5, i = id & 31;
                  const float inv = exp2f(-(float)(2 * i) * (13.287712379549449f / 64.0f)); const float ang = (float)s * inv;
                  float sv, cv; sincosf(ang, &sv, &cv); stf(cs + id, cv); stf(sn + id, sv); } }
            __syncthreads();
        if (p.ph_hi < 0) cg::this_grid().sync();
        if (1 < p.ph_hi) xcd_barrier(xbar);
    }
    for (int ph = (p.ph_lo < 1 ? 1 : p.ph_lo); ph < p.ph_hi; ++ph) {
        if ((ph >= 8 && ph <= 10) || (ph >= 19 && ph <= 21)) continue;
        unsigned char* ws = p.ws; float* X = p.out; int bid = blockIdx.x;
        LAUNDER_P(ws); LAUNDER_P(X); asm volatile("" : "+s"(bid));
        const int G = gridDim.x, gsz = G * 512;
        bf16_t* const XB = (bf16_t*)(ws + XB_OFF); float* const SSPp = (float*)(ws + SSP_OFF); float* const MSSP = (float*)(ws + MSSP_OFF);
        bf16_t* const MEMB = (bf16_t*)(ws + MEMB_OFF); float* const TAB = (float*)(ws + TAB_OFF);
        if (ph == 2) {
            int tid = threadIdx.x; LAUNDER_V(tid); LAUNDER_P(ws);
            const float* lq1 = p.in[10]; const float* lk1 = p.in[11]; const float* lq2 = p.in[12]; const float* lk2 = p.in[13];
            float s1 = 0.f, s2 = 0.f;
            for (int i = 0; i < 64; ++i) { s1 += lq1[i] * lk1[i]; s2 += lq2[i] * lk2[i]; }
            const float lam = expf(s1) - expf(s2) + 0.2f;
            const bf16_t* QK = (const bf16_t*)(ws + QK_OFF); const bf16_t* VT = (const bf16_t*)(ws + VT_OFF); bf16_t* Ob = (bf16_t*)(ws + O_OFF);
            const int xcd = bid & 7, slot = bid >> 3;
            for (int i = 0; i < 20; ++i) {
                int b, h, qb, S, tok0;
                if (i < 16) { const int bh = i * 8 + xcd; qb = slot; b = bh >> 3; h = bh & 7; S = SP; tok0 = b * SP; }
                else { const int bh = (i - 16) * 16 + xcd * 2 + (slot >> 4); qb = slot & 15; b = bh >> 3; h = bh & 7; S = SS; tok0 = TP + b * SS; }
                attn_unit<64, 128, true>(lds, QK + (size_t)(tok0 + qb * 128) * 2048 + h * 128, 2048, QK + (size_t)tok0 * 2048 + 1024 + h * 128, 2048,
                                 VT + (size_t)(h * 128) * T + tok0, (size_t)T, S, Ob + (size_t)(tok0 + qb * 128) * D + h * 128, lam, p.in[14], tid);
            }
        } else if (ph == 5 || ph == 16) {
            int tid = threadIdx.x; LAUNDER_V(tid); LAUNDER_P(ws);
            const int l = (ph == 5) ? 0 : 1;
            const bf16_t* QX = (const bf16_t*)(ws + QX_OFF); const bf16_t* KM = (const bf16_t*)(ws + KMEM_OFF + l * 12 * MiB); const bf16_t* VM = (const bf16_t*)(ws + VMT_OFF + l * 12 * MiB);
            bf16_t* Ob = (bf16_t*)(ws + O_OFF);
            for (int i = 0; i < 10; ++i) {
                const int u = i * 256 + bid; int eh, qb, h, b, tok0, mem0;
                if (u < 2048) { eh = u & 1; qb = (u >> 1) & 15; h = (u >> 5) & 3; b = u >> 7; tok0 = b * SP; mem0 = b * 256; }
                else { const int v = u - 2048; eh = v & 1; qb = (v >> 1) & 7; h = (v >> 4) & 3; b = v >> 6; tok0 = TP + b * SS; mem0 = 4096 + b * 256; }
                attn_unit<256, 256, false>(lds, QX + (size_t)(tok0 + qb * 256) * D + h * 256, D, KM + (size_t)mem0 * D + h * 256, D,
                                  VM + (size_t)(h * 256 + eh * 128) * NMEMR + mem0, (size_t)NMEMR, 256, Ob + (size_t)(tok0 + qb * 256) * D + h * 256 + eh * 128, 0.f, nullptr, tid);
            }
        } else if (ph == 23) {
            int tid = threadIdx.x; LAUNDER_V(tid); LAUNDER_P(X); LAUNDER_P(ws);
            const float* gf = p.in[8]; const float* ss6 = (const float*)(ws + SSP_OFF + 6 * SSQ_STRIDE); const bf16_t* xbf = (const bf16_t*)(ws + XB_OFF);
            for (int r = bid * 4 + (tid >> 7); r < T; r += G * 4) {
                const int c0 = (tid & 127) * 8; const float rs = rowscale16(ss6, r, 1e-6f);
                const u32x4 q = __builtin_nontemporal_load((const GAS u32x4*)(xbf + (size_t)r * D + c0));
                const f32x4 a = {bflo(q.x), bfhi(q.x), bflo(q.y), bfhi(q.y)}, b = {bflo(q.z), bfhi(q.z), bflo(q.w), bfhi(q.w)};
                const f32x4 g0 = *(const GAS f32x4*)(gf + c0), g1 = *(const GAS f32x4*)(gf + c0 + 4);
                float* xp = X + (size_t)r * D + c0;
                __builtin_nontemporal_store(a * rs * g0, (GAS f32x4*)xp); __builtin_nontemporal_store(b * rs * g1, (GAS f32x4*)(xp + 4));
            }
        } else {
            if (ph == 12) {
                int tid = threadIdx.x; LAUNDER_V(tid); LAUNDER_P(ws); const int gtid = bid * 512 + tid;
                LAS float* tab = (LAS float*)lds;
#pragma unroll
                for (int i = 0; i < 8; ++i) tab[tid + 512 * i] = ldf(TAB + tid + 512 * i);
                __syncthreads();
                int msk = 4095; LAUNDER_S(msk);
                for (int tb = 0; tb < 4; ++tb) {
                    bf16_t* dst = (bf16_t*)(ws + (tb == 0 ? COSP_OFF : tb == 1 ? SINP_OFF : tb == 2 ? COSS_OFF : SINS_OFF));
                    const int rows = tb == 0 ? 2304 : tb == 1 ? 2048 : tb == 2 ? 1280 : 1024, lg = tb < 2 ? 9 : 8, mul = tb < 2 ? 1 : 2, off = (tb & 1) ? 1024 : 0;
                    const float sg = (tb & 1) ? -1.0f : 1.0f;
                    for (int id = gtid; id < (rows << lg); id += gsz) { const int nn = id >> lg, j0 = (id & ((1 << lg) - 1)) * 8; float v[8];
                        const int base = mul * nn * j0 + off;
#pragma unroll
                        for (int i = 0; i < 8; ++i) v[i] = sg * tab[(base + mul * nn * i) & msk];
                        u32x4 w; w.x = pkbf(v[0], v[1]); w.y = pkbf(v[2], v[3]); w.z = pkbf(v[4], v[5]); w.w = pkbf(v[6], v[7]);
                        *(GAS u32x4*)(dst + ((size_t)nn << (lg + 3)) + j0) = w; }
                }
                bf16_t* ap = (bf16_t*)(ws + ACATP_OFF); bf16_t* as = (bf16_t*)(ws + ACATS_OFF);
                for (int q = 0; q < 16 * 8; ++q) { const int b = q >> 3, g = (q >> 1) & 3, mm = (q & 1) * 128; zero_fill(ap + ((size_t)8448 + (size_t)(b * 516 + g * 129 + mm)) * SP, SP * 2, gtid, gsz); }
                for (int q = 0; q < 8 * 8; ++q) { const int b = q >> 3, g = (q >> 1) & 3, mm = (q & 1) * 128; zero_fill(as + ((size_t)4352 + (size_t)(b * 516 + g * 129 + mm)) * SS, SS * 2, gtid, gsz); }
                for (int part = 0; part < 2; ++part) {
                    zero_fill(ap + ((size_t)part * 8448 + 8256) * SP, (size_t)(8448 - 8256) * SP * 2, gtid, gsz);
                    zero_fill(as + ((size_t)part * 4352 + 4128) * SS, (size_t)(4352 - 4128) * SS * 2, gtid, gsz);
                }
                __syncthreads();
            }
            for (int j = 0; j < (ph == 24 ? 0 : 6); ++j) {
                unsigned char* wj = ws; LAUNDER_P(wj);
                const int cidx = ph <= 1 ? 0 : ph <= 4 ? 1 : ph <= 10 ? 2 : ph <= 12 ? 3 : ph <= 15 ? 4 : ph <= 21 ? 5 : 6;
                const bf16_t* const XBj = (const bf16_t*)(wj + XB_OFF); const bf16_t* const MEMBj = (const bf16_t*)(wj + MEMB_OFF);
                Job jb; jb.type = -1; jb.rot = 0; jb.l = 0; jb.h = 0; jb.K = D; jb.M = T; jb.N = D; jb.A = XBj; jb.Bt = nullptr;
                const int l = (ph >= 15) ? 1 : 0;
                if (ph == 1) {
                    if (j == 0) { jb.type = T_QK; jb.Bt = (const bf16_t*)(wj + W_QK); jb.N = 2048; }
                    else if (j == 1) { jb.type = T_COL; jb.A = (const bf16_t*)(wj + W_V); jb.Bt = XBj; jb.M = 1024; jb.N = T; jb.l = 2; }
                    else if (j < 4) { jb.type = T_ROW; jb.l = j - 2; jb.h = 2; jb.A = MEMBj; jb.Bt = (const bf16_t*)(wj + W_XK + (j - 2) * 2 * MiB); jb.M = NMEMR; jb.rot = (j - 2) * 96; }
                    else { jb.type = T_COL; jb.l = j - 4; jb.A = (const bf16_t*)(wj + W_XV + (j - 4) * 2 * MiB); jb.Bt = MEMBj; jb.M = 1024; jb.N = NMEMR; jb.rot = 192 + (j - 4) * 96; }
                } else if (j == 0 || (ph == 13 && j <= 3)) {
                    if (ph == 3) { jb.type = T_RES; jb.A = (const bf16_t*)(wj + O_OFF); jb.Bt = (const bf16_t*)(wj + W_O); jb.h = 1; }
                    else if (ph == 4 || ph == 15) { jb.type = T_ROW; jb.Bt = (const bf16_t*)(wj + W_XQ + l * 2 * MiB); jb.l = l; jb.h = 0; }
                    else if (ph == 6 || ph == 17) { jb.type = T_RES; jb.A = (const bf16_t*)(wj + O_OFF); jb.Bt = (const bf16_t*)(wj + W_XO + l * 2 * MiB); }
                    else if (ph == 7 || ph == 18) { jb.type = T_GLU; jb.l = l; jb.Bt = (const bf16_t*)(wj + W_G + l * 2 * WFFN); jb.M = 323 * 256; jb.N = 2 * FF; jb.h = 1; }
                    else if (ph == 11 || ph == 22) { jb.type = T_RES; jb.A = (const bf16_t*)(wj + U_OFF); jb.Bt = (const bf16_t*)(wj + W_D + l * WFFN); jb.K = FF; }
                    else if (ph == 12) { jb.type = T_FZ; jb.A = (const bf16_t*)(wj + W_AB); jb.Bt = XBj; jb.M = 1024; jb.N = T; }
                    else if (ph == 13) { jb.type = T_DFT; jb.l = j;
                        if (j == 0) { jb.A = (const bf16_t*)(wj + ACATP_OFF); jb.Bt = (const bf16_t*)(wj + COSP_OFF); jb.M = 8448; jb.N = 2304; jb.K = SP; }
                        else if (j == 1) { jb.A = (const bf16_t*)(wj + ACATP_OFF) + (size_t)8448 * SP; jb.Bt = (const bf16_t*)(wj + SINP_OFF); jb.M = 8448; jb.N = 2048; jb.K = SP; jb.rot = 215; }
                        else if (j == 2) { jb.A = (const bf16_t*)(wj + ACATS_OFF); jb.Bt = (const bf16_t*)(wj + COSS_OFF); jb.M = 4352; jb.N = 1280; jb.K = SS; jb.rot = 207; }
                        else { jb.A = (const bf16_t*)(wj + ACATS_OFF) + (size_t)4352 * SS; jb.Bt = (const bf16_t*)(wj + SINS_OFF); jb.M = 4352; jb.N = 1024; jb.K = SS; jb.rot = 122; } }
                    else if (ph == 14) { jb.type = T_RES; jb.A = (const bf16_t*)(wj + FB_OFF); jb.Bt = (const bf16_t*)(wj + W_FO); }
                }
                if (jb.type < 0) break;
                pg8::Gemm gm; gm.A = jb.A; gm.Bt = jb.Bt; gm.M = jb.M; gm.N = jb.N; gm.K = jb.K;
                pg8::StaticOrder So; So.init(jb.M, jb.N, G, (bid + jb.rot) % G, jb.type == T_GLU ? 1 : 0);
                if (jb.type == T_QK) { EpiQK E; unsigned char* wsl = ws; LAUNDER_P(wsl); E.O = (bf16_t*)(wsl + QK_OFF); E.ssp = (float*)(wsl + SSP_OFF + cidx * SSQ_STRIDE); E.cs = (const float*)(wsl + ROPE_C); E.sn = (const float*)(wsl + ROPE_S); E.qscale = 0.125f * 1.4426950409f;
                    { int tl = threadIdx.x; LAUNDER_V(tl); pg8::gemm_phase(lds, gm, So, E, tl); } }
                else if (jb.type == T_COL) { EpiCol E; unsigned char* wsl = ws; LAUNDER_P(wsl);
                    if (jb.l == 2) { E.O = (bf16_t*)(wsl + VT_OFF); E.ld = T; E.ssp = (float*)(wsl + SSP_OFF + cidx * SSQ_STRIDE); } else { E.O = (bf16_t*)(wsl + VMT_OFF + jb.l * 12 * MiB); E.ld = NMEMR; E.ssp = (float*)(wsl + MSSP_OFF); }
                    { int tl = threadIdx.x; LAUNDER_V(tl); pg8::gemm_phase(lds, gm, So, E, tl); } }
                else if (jb.type == T_FZ) { EpiFZ E; unsigned char* wsl = ws; LAUNDER_P(wsl); E.AP = (bf16_t*)(wsl + ACATP_OFF); E.AS = (bf16_t*)(wsl + ACATS_OFF); E.ssp = (float*)(wsl + SSP_OFF + cidx * SSQ_STRIDE); { int tl = threadIdx.x; LAUNDER_V(tl); pg8::gemm_phase(lds, gm, So, E, tl); } }
                else if (jb.type == T_ROW) { EpiRow E; unsigned char* wsl = ws; LAUNDER_P(wsl);
                    if (jb.h == 0) { E.O = (bf16_t*)(wsl + QX_OFF); E.ldo = D; E.ssp = (float*)(wsl + SSP_OFF + cidx * SSQ_STRIDE); E.scale = 0.0625f * 1.4426950409f; E.rbase = 0; }
                    else { E.O = (bf16_t*)(wsl + KMEM_OFF + jb.l * 12 * MiB); E.ldo = D; E.ssp = (float*)(wsl + MSSP_OFF); E.scale = 1.0f; E.rbase = 0; }
                    { int tl = threadIdx.x; LAUNDER_V(tl); pg8::gemm_phase(lds, gm, So, E, tl); } }
                else if (jb.type == T_RES) { EpiRes E; unsigned char* wsl = ws; LAUNDER_P(wsl); E.XB = (bf16_t*)(wsl + XB_OFF); E.ssp = (float*)(wsl + SSP_OFF + cidx * SSQ_STRIDE);
                    { int tl = threadIdx.x; LAUNDER_V(tl); pg8::gemm_phase(lds, gm, So, E, tl); } }
                else if (jb.type == T_GLU) { EpiUp E; unsigned char* wsl = ws; LAUNDER_P(wsl); E.U = (bf16_t*)(wsl + U_OFF); E.ssp = (float*)(wsl + SSP_OFF + cidx * SSQ_STRIDE); E.cw = p.in[22] + (size_t)jb.l * 3 * FF; E.cb = p.in[23] + (size_t)jb.l * FF; E.ex = (LAS float*)(lds + 131072);
                    { int tl = threadIdx.x; LAUNDER_V(tl); pg8::gemm_phase(lds, gm, So, E, tl); } }
                else { EpiDFT E; unsigned char* wsl = ws; LAUNDER_P(wsl);
                    E.O = (bf16_t*)(wsl + (jb.l == 0 ? PP_OFF : jb.l == 1 ? QP_OFF : jb.l == 2 ? PS_OFF : QS_OFF)); E.ldo = jb.N;
                    { int tl = threadIdx.x; LAUNDER_V(tl); pg8::gemm_phase(lds, gm, So, E, tl); } }
            }
            if ((ph == 13 && p.ph_hi - p.ph_lo > 1) || ph == 24) {
                if (ph == 13) xcd_barrier(xbar);
                int tid = threadIdx.x; LAUNDER_V(tid); unsigned char* wc_ = ws; LAUNDER_P(wc_);
                dft_combine(lds, (const bf16_t*)(wc_ + PP_OFF), 2304, (const bf16_t*)(wc_ + QP_OFF), 2048, (bf16_t*)(wc_ + FB_OFF), SP, 16, 1.0f / 1024.0f, bid, G, tid);
                dft_combine(lds, (const bf16_t*)(wc_ + PS_OFF), 1280, (const bf16_t*)(wc_ + QS_OFF), 1024, (bf16_t*)(wc_ + FB_OFF) + (size_t)TP * D, SS, 8, 0.0013810679f, bid, G, tid);
            }
        }
        if (ph + 1 < p.ph_hi) xcd_barrier(xbar);
    }
}

extern "C" void kernel_launch(void* const* d_in, const int* in_sizes, int n_in, void* d_out, int out_size, void* d_ws, size_t ws_size, hipStream_t stream) {
    static int grid = 0;
    if (grid == 0) {
        if (n_in != 25 || out_size != T * D || ws_size < WS_NEED) { fprintf(stderr, "kernel_launch: unexpected shapes (n_in %d out %d ws %zu need %zu)\n", n_in, out_size, ws_size, (size_t)WS_NEED); grid = -1; return; }
        if (hipFuncSetAttribute((const void*)mk_fwd, hipFuncAttributeMaxDynamicSharedMemorySize, LDS_BYTES) != hipSuccess) { fprintf(stderr, "kernel_launch: hipFuncSetAttribute failed\n"); grid = -1; return; }
        int dev = 0, cus = 0, per_cu = 0;
        (void)hipGetDevice(&dev); (void)hipDeviceGetAttribute(&cus, hipDeviceAttributeMultiprocessorCount, dev);
        (void)hipOccupancyMaxActiveBlocksPerMultiprocessor(&per_cu, (const void*)mk_fwd, 512, LDS_BYTES);
        if (per_cu < 1) fprintf(stderr, "kernel_launch: occupancy query says %d blocks per CU\n", per_cu);
        (void)hipGetLastError();
        grid = cus > 0 ? cus : 256;
        if (grid > 256) grid = 256;
    }
    if (grid < 0) return;
    Params p{};
    for (int i = 0; i < 25; ++i) p.in[i] = (const float*)d_in[i];
    p.out = (float*)d_out; p.ws = (unsigned char*)d_ws;
#if MK_COOP
    p.ph_lo = 0; p.ph_hi = NPH;
    (void)hipMemsetAsync((unsigned char*)d_ws + BAR_OFF, 0, 16384, stream);
    void* args[] = {&p};
    hipError_t e = hipLaunchCooperativeKernel((const void*)mk_fwd, dim3(grid), dim3(512), args, LDS_BYTES, stream);
    if (e != hipSuccess) fprintf(stderr, "kernel_launch: cooperative launch failed: %s (grid %d)\n", hipGetErrorString(e), grid);
#else
    for (int ph = 0; ph < NPH; ++ph) { p.ph_lo = ph; p.ph_hi = ph + 1; hipLaunchKernelGGL(mk_fwd, dim3(grid), dim3(512), LDS_BYTES, stream, p);
        if (ph == 13) { p.ph_lo = 24; p.ph_hi = 25; hipLaunchKernelGGL(mk_fwd, dim3(grid), dim3(512), LDS_BYTES, stream, p); } }
#endif
}
```
